# Optimizing an MI355X kernel written in HIP

```python
import jax, jax.numpy as jnp
from jax import lax
import numpy as np

D_MODEL = 1024
BATCH = 8
SEQ = 2048
DEPTH = 1

CONV_CH = 512
N_CONV_GROUPS = 8
ATTN_HEADS = 8
HEAD_DIM = 64
ATTN_WIDTH = ATTN_HEADS * HEAD_DIM
MIX_WIDTH = CONV_CH + ATTN_WIDTH
IN_WIDTH = 2 * CONV_CH + 3 * ATTN_WIDTH
CONV_KERNEL = 31
MOBA_BLOCK = 256
MOBA_TOPK = 3
QUERY_CHUNK = 32
ROPE_THETA = 500000.0
ROPE_DIM = HEAD_DIM // 4
D_FF = -(-8 * D_MODEL // (3 * 256)) * 256
PLE_DIM = 256
EPS = 1e-6

kernel_name = "hymba_conformer_moba_hybrid"


def rmsnorm(x, g):
    xf = x.astype(jnp.float32)
    y = xf * lax.rsqrt(jnp.mean(xf * xf, axis=-1, keepdims=True) + EPS)
    return (y * g.astype(jnp.float32)).astype(x.dtype)


def layernorm(x, g, b):
    xf = x.astype(jnp.float32)
    mu = jnp.mean(xf, axis=-1, keepdims=True)
    var = jnp.mean(jnp.square(xf - mu), axis=-1, keepdims=True)
    y = (xf - mu) * lax.rsqrt(var + EPS)
    return (y * g.astype(jnp.float32) + b.astype(jnp.float32)).astype(x.dtype)


def rope_tables(positions, dtype):
    inv_freq = ROPE_THETA ** (-jnp.arange(0, ROPE_DIM, 2, dtype=jnp.float32) / ROPE_DIM)
    ang = positions.astype(jnp.float32)[..., None] * inv_freq
    return jnp.cos(ang)[:, None].astype(dtype), jnp.sin(ang)[:, None].astype(dtype)


def apply_partial_rope(x, cos, sin):
    half = ROPE_DIM // 2
    x1, x2, rest = x[..., :half], x[..., half:ROPE_DIM], x[..., ROPE_DIM:]
    return jnp.concatenate([x1 * cos - x2 * sin, x2 * cos + x1 * sin, rest], axis=-1)


def conv_mixer(a, g, w_dw, b_dw, ln_g, ln_b):
    u = a * jax.nn.sigmoid(g)
    c = u.shape[-1]
    u = lax.conv_general_dilated(
        u, w_dw.astype(u.dtype)[:, None, :], window_strides=(1,),
        padding=[(CONV_KERNEL - 1, 0)], dimension_numbers=("NWC", "WIO", "NWC"),
        feature_group_count=c) + b_dw.astype(u.dtype)
    return jax.nn.silu(layernorm(u, ln_g, ln_b))


def moba_attention(q, k, v):
    B, H, S, Dh = q.shape
    nb = -(-S // MOBA_BLOCK)
    s_pad = nb * MOBA_BLOCK
    topk = min(MOBA_TOPK, nb)
    pad = ((0, 0), (0, 0), (0, s_pad - S), (0, 0))
    kp = jnp.pad(k, pad)
    vp = jnp.pad(v, pad)
    k_blk = kp.reshape(B, H, nb, MOBA_BLOCK, Dh)
    v_blk = vp.reshape(B, H, nb, MOBA_BLOCK, Dh)
    k_mean = jnp.mean(k_blk.astype(jnp.float32), axis=3)
    scale = Dh ** -0.5
    n_chunks = S // QUERY_CHUNK
    q_chunks = q.reshape(B, H, n_chunks, QUERY_CHUNK, Dh).transpose(2, 0, 1, 3, 4)
    b_idx = jnp.arange(B)[:, None, None, None]
    h_idx = jnp.arange(H)[None, :, None, None]
    neg = jnp.finfo(jnp.float32).min

    def one_chunk(args):
        qc, c = args
        q_start = c * QUERY_CHUNK
        own = q_start // MOBA_BLOCK
        q_pos = q_start + jnp.arange(QUERY_CHUNK)
        gate = jnp.einsum('bhqd,bhnd->bhqn', qc.astype(jnp.float32), k_mean)
        gate = jnp.where(jnp.arange(nb) < own, gate, neg)
        _, sel = lax.top_k(gate, topk)
        slot_valid = jnp.arange(topk) < own
        k_sel = k_blk[b_idx, h_idx, sel]
        v_sel = v_blk[b_idx, h_idx, sel]
        s_sel = jnp.einsum('bhqd,bhqtkd->bhqtk', qc, k_sel).astype(jnp.float32) * scale
        s_sel = jnp.where(slot_valid[:, None], s_sel, neg)
        s_sel = s_sel.reshape(B, H, QUERY_CHUNK, topk * MOBA_BLOCK)
        k_own = lax.dynamic_slice_in_dim(kp, own * MOBA_BLOCK, MOBA_BLOCK, axis=2)
        v_own = lax.dynamic_slice_in_dim(vp, own * MOBA_BLOCK, MOBA_BLOCK, axis=2)
        s_own = jnp.einsum('bhqd,bhkd->bhqk', qc, k_own).astype(jnp.float32) * scale
        k_pos = own * MOBA_BLOCK + jnp.arange(MOBA_BLOCK)
        s_own = jnp.where(k_pos[None, :] <= q_pos[:, None], s_own, neg)
        probs = jax.nn.softmax(jnp.concatenate([s_sel, s_own], axis=-1), axis=-1)
        p_sel = probs[..., :topk * MOBA_BLOCK].reshape(B, H, QUERY_CHUNK, topk, MOBA_BLOCK)
        p_own = probs[..., topk * MOBA_BLOCK:]
        return (jnp.einsum('bhqtk,bhqtkd->bhqd', p_sel.astype(v.dtype), v_sel)
                + jnp.einsum('bhqk,bhkd->bhqd', p_own.astype(v.dtype), v_own))

    out = lax.map(one_chunk, (q_chunks, jnp.arange(n_chunks)))
    return out.transpose(1, 2, 0, 3, 4).reshape(B, H, S, Dh)


def setup_inputs(seed: int = 0) -> dict:
    key = jax.random.key(seed)
    ks = jax.random.split(key, 20)
    f32 = jnp.float32
    nrm = lambda k, shape, s: jax.random.normal(k, shape, f32) * s
    gain = lambda k, shape: 1.0 + 0.05 * jax.random.normal(k, shape, f32)
    return {
        "x": jax.random.normal(ks[0], (BATCH, SEQ, D_MODEL), f32),
        "p": jax.random.normal(ks[1], (DEPTH, BATCH, SEQ, PLE_DIM), f32),
        "positions": jnp.broadcast_to(jnp.arange(SEQ, dtype=jnp.int32), (BATCH, SEQ)),
        "norm_mix_g": gain(ks[2], (DEPTH, D_MODEL)),
        "w_in": nrm(ks[3], (DEPTH, D_MODEL, IN_WIDTH), D_MODEL ** -0.5),
        "conv_w": nrm(ks[4], (DEPTH, CONV_KERNEL, CONV_CH), CONV_KERNEL ** -0.5),
        "conv_b": nrm(ks[5], (DEPTH, CONV_CH), 0.02),
        "conv_ln_g": gain(ks[6], (DEPTH, CONV_CH)),
        "conv_ln_b": nrm(ks[7], (DEPTH, CONV_CH), 0.02),
        "w_out": nrm(ks[8], (DEPTH, MIX_WIDTH, D_MODEL), MIX_WIDTH ** -0.5),
        "norm_ffn_g": gain(ks[9], (DEPTH, D_MODEL)),
        "w_ffn_up": nrm(ks[10], (DEPTH, D_MODEL, 2 * D_FF), D_MODEL ** -0.5),
        "w_ffn_down": nrm(ks[11], (DEPTH, D_FF, D_MODEL), D_FF ** -0.5),
        "norm_ple_g": gain(ks[12], (DEPTH, D_MODEL)),
        "w_ple_gate": nrm(ks[13], (DEPTH, D_MODEL, D_MODEL), D_MODEL ** -0.5),
        "w_ple_proj": nrm(ks[14], (DEPTH, PLE_DIM, D_MODEL), PLE_DIM ** -0.5),
        "final_norm_g": gain(ks[15], (D_MODEL,)),
    }


def reference(x, p, positions, norm_mix_g, w_in, conv_w, conv_b, conv_ln_g, conv_ln_b,
              w_out, norm_ffn_g, w_ffn_up, w_ffn_down, norm_ple_g, w_ple_gate,
              w_ple_proj, final_norm_g):
    B, S, _ = x.shape
    cos, sin = rope_tables(positions, x.dtype)
    splits = [CONV_CH, 2 * CONV_CH, 2 * CONV_CH + ATTN_WIDTH, 2 * CONV_CH + 2 * ATTN_WIDTH]
    to_heads = lambda t: t.reshape(B, S, ATTN_HEADS, HEAD_DIM).transpose(0, 2, 1, 3)
    h = x
    for i in range(DEPTH):
        hn = rmsnorm(h, norm_mix_g[i])
        z = hn @ w_in[i]
        a, g, q, k, v = jnp.split(z, splits, axis=-1)
        conv_out = conv_mixer(a, g, conv_w[i], conv_b[i], conv_ln_g[i], conv_ln_b[i])
        q = apply_partial_rope(to_heads(q), cos, sin)
        k = apply_partial_rope(to_heads(k), cos, sin)
        attn = moba_attention(q, k, to_heads(v))
        attn = attn.transpose(0, 2, 1, 3).reshape(B, S, ATTN_WIDTH)
        h = h + jnp.concatenate([conv_out, attn], axis=-1) @ w_out[i]
        hn = rmsnorm(h, norm_ffn_g[i])
        gt, up = jnp.split(hn @ w_ffn_up[i], 2, axis=-1)
        h = h + (jax.nn.silu(gt) * up) @ w_ffn_down[i]
        gate = jax.nn.sigmoid(rmsnorm(h, norm_ple_g[i]) @ w_ple_gate[i])
        h = h + gate * (p[i].astype(h.dtype) @ w_ple_proj[i])
    return rmsnorm(h, final_norm_g)
```

```cpp
#include <hip/hip_runtime.h>
#include <hip/hip_cooperative_groups.h>
#include <cstdio>
#include <cstdint>
#include <cmath>
namespace cg = cooperative_groups;
#ifndef MK_MULTI_LAUNCH
#define MK_ONE_LAUNCH 1
#endif

#define LAS __attribute__((address_space(3)))
#define GAS __attribute__((address_space(1)))
typedef _Float16 f16_t;
typedef _Float16 f16x8 __attribute__((ext_vector_type(8)));
typedef _Float16 f16x4 __attribute__((ext_vector_type(4)));
typedef _Float16 f16x2 __attribute__((ext_vector_type(2)));
typedef float f32x2 __attribute__((ext_vector_type(2)));
typedef float f32x4 __attribute__((ext_vector_type(4)));
typedef float f32x16 __attribute__((ext_vector_type(16)));
typedef unsigned u32x4 __attribute__((ext_vector_type(4)));
typedef unsigned u32x2 __attribute__((ext_vector_type(2)));

constexpr int BATCH = 8, SEQ = 2048, D = 1024, M = BATCH * SEQ;
constexpr int CONV_CH = 512, NHEAD = 8, HD = 64, AW = 512, INW = 2560, DFF = 2816, PLE = 256, CONVK = 31, MOBA = 256, NBLK = SEQ / MOBA;
constexpr float EPS = 1e-6f;
constexpr float LOG2E = 1.4426950408889634f;
constexpr float C2 = 0.125f * 1.4426950408889634f;

__device__ __forceinline__ unsigned pkh(float lo, float hi) { f32x2 v = {lo, hi}; f16x2 h = __builtin_convertvector(v, f16x2); return __builtin_bit_cast(unsigned, h); }
__device__ __forceinline__ float sigmoidf_(float x) { return __builtin_amdgcn_rcpf(1.0f + __builtin_amdgcn_exp2f(-x * LOG2E)); }

namespace pg8 {
constexpr int BM = 256, BK = 64, HALF = 128, HTB = HALF * BK * 2, STAGE_BYTES = 8 * HTB, NXCD = 8, WGM = 8;
__host__ __device__ __forceinline__ int lds_byte(int r, int c) { const int st = (r >> 4) * 2 + (c >> 5), rr = r & 15, cc = c & 31, ob = rr * 64 + cc * 2; return st * 1024 + (ob ^ (((ob >> 9) & 1) << 5)); }
__host__ __device__ __forceinline__ void stage_rc(int b, int& R, int& C) { const int st = b / 1024, sb = b % 1024, swz = sb ^ (((sb >> 9) & 1) << 5); R = (st >> 1) * 16 + swz / 64; C = (st & 1) * 32 + (swz % 64) / 2; }
__host__ __device__ __forceinline__ int perm32(int rho) { const int n = rho >> 4, i = rho & 15; return 8 * (i >> 2) + 4 * n + (i & 3); }

__device__ __forceinline__ void glds16s(unsigned voff, const void* sbase, unsigned lds_dst) { unsigned keep;
    asm volatile("s_mov_b32 %0, m0\n\ts_mov_b32 m0, %3\n\ts_nop 0\n\tglobal_load_lds_dwordx4 %1, %2\n\ts_mov_b32 m0, %0" : "=&s"(keep) : "v"(voff), "s"(sbase), "s"(lds_dst) : "memory"); }
struct Unit { int pm, pn; };
struct Gemm { const f16_t* A; const f16_t* Bt; int M, N, K; };

struct StaticOrder {
    int nM, nN, nwg, G, c;
    __host__ __device__ void init(int M_, int N_, int G_, int c_) { nM = M_ / BM; nN = N_ / BM; nwg = nM * nN; G = G_; c = c_; }
    __host__ __device__ bool next(int i, Unit& u) const {
        const long L = (long)i * G + c; if (L >= nwg) return false;
        int wgid = (int)L; { const int q = nwg / NXCD, r = nwg % NXCD, xcd = wgid % NXCD, off = wgid / NXCD; wgid = (xcd < r ? xcd * (q + 1) : r * (q + 1) + (xcd - r) * q) + off; }
        const int nig = WGM * nN, gid = wgid / nig, fm = gid * WGM, gsz = (nM - fm) < WGM ? (nM - fm) : WGM;
        u.pm = fm + ((wgid % nig) % gsz); u.pn = (wgid % nig) / gsz; return true;
    }
    __device__ __forceinline__ void a_ready(const Unit&) const {}
    __device__ __forceinline__ void done(const Unit&) const {}
};
struct ListOrder {
    int first, count, nN;
    __device__ __forceinline__ bool next(int i, Unit& u) const { if (i >= count) return false; const int L = first + i; u.pm = L / nN; u.pn = L % nN; return true; }
    __device__ __forceinline__ void a_ready(const Unit&) const {}
    __device__ __forceinline__ void done(const Unit&) const {}
};


struct EpiIn {
    static constexpr bool PERM = true, AFTER_DRAIN = false;
    f16_t* U; f16_t* MIX; f16_t* Kb; f16_t* Vb; const float* ropec; const float* ropes; float* kms;
    __device__ __forceinline__ void operator()(const f32x4 (&acc)[2][2][4][2], const Unit& u, int wr, int wc, int fr_, int fq_) const {
        int t_ = threadIdx.x; asm volatile("" : "+v"(t_)); const int fr = t_ & 15, fq = (t_ >> 4) & 3;
        const int row0 = u.pm * BM + wr * 64 + fr;
        const int cw = wc * 32 + 8 * fq;
        if (u.pn < 4) {
#pragma unroll
            for (int ai = 0; ai < 2; ++ai)
#pragma unroll
                for (int m = 0; m < 4; ++m) {
                    const int row = row0 + ai * HALF + m * 16;
                    const f32x4 a0 = acc[ai][0][m][0], a1 = acc[ai][0][m][1], g0 = acc[ai][1][m][0], g1 = acc[ai][1][m][1];
                    u32x4 w;
                    w.x = pkh(a0[0] * sigmoidf_(g0[0]), a0[1] * sigmoidf_(g0[1])); w.y = pkh(a0[2] * sigmoidf_(g0[2]), a0[3] * sigmoidf_(g0[3]));
                    w.z = pkh(a1[0] * sigmoidf_(g1[0]), a1[1] * sigmoidf_(g1[1])); w.w = pkh(a1[2] * sigmoidf_(g1[2]), a1[3] * sigmoidf_(g1[3]));
                    *(u32x4*)(U + (size_t)row * CONV_CH + 128 * u.pn + cw) = w;
                }
        } else if (u.pn < 8) {
            const bool isq = u.pn < 6;
            const int ct = (u.pn - (isq ? 4 : 6)) * 256;
            const bool ropew = (wc & 1) == 0;
            const float sgn = (fq == 0) ? -1.f : 1.f;
            const bool ropel = fq < 2;
            float cs[2][8];
#pragma unroll
            for (int bj = 0; bj < 2; ++bj)
#pragma unroll
                for (int e = 0; e < 8; ++e) cs[bj][e] = 0.f;
#pragma unroll
            for (int ai = 0; ai < 2; ++ai)
#pragma unroll
                for (int m = 0; m < 4; ++m) {
                    const int row = row0 + ai * HALF + m * 16;
                    f32x4 c0 = {1.f, 1.f, 1.f, 1.f}, c1 = c0, s0 = {0.f, 0.f, 0.f, 0.f}, s1 = s0;
                    if (ropew) { c0 = *(const f32x4*)(ropec + (size_t)row * 8); c1 = *(const f32x4*)(ropec + (size_t)row * 8 + 4); s0 = *(const f32x4*)(ropes + (size_t)row * 8); s1 = *(const f32x4*)(ropes + (size_t)row * 8 + 4); }
#pragma unroll
                    for (int bj = 0; bj < 2; ++bj) {
                        f32x4 v0 = acc[ai][bj][m][0], v1 = acc[ai][bj][m][1];
                        if (ropew) {
                            f32x4 p0, p1;
#pragma unroll
                            for (int e = 0; e < 4; ++e) { p0[e] = __shfl_xor(v0[e], 16); p1[e] = __shfl_xor(v1[e], 16); }
                            if (ropel) { v0 = v0 * c0 + (p0 * s0) * sgn; v1 = v1 * c1 + (p1 * s1) * sgn; }
                        }
                        if (isq) {
                            v0 = v0 * C2; v1 = v1 * C2;
                            u32x4 w; w.x = pkh(v0[0], v0[1]); w.y = pkh(v0[2], v0[3]); w.z = pkh(v1[0], v1[1]); w.w = pkh(v1[2], v1[3]);
                            *(u32x4*)(MIX + (size_t)row * D + AW + ct + bj * HALF + cw) = w;
                        } else {
#pragma unroll
                            for (int e = 0; e < 4; ++e) { cs[bj][e] += v0[e]; cs[bj][4 + e] += v1[e]; }
                            u32x4 w; w.x = pkh(v0[0], v0[1]); w.y = pkh(v0[2], v0[3]); w.z = pkh(v1[0], v1[1]); w.w = pkh(v1[2], v1[3]);
                            *(u32x4*)(Kb + (size_t)row * AW + ct + bj * HALF + cw) = w;
                        }
                    }
                    asm volatile("" ::: "memory");
                }
            if (!isq) {
#pragma unroll
                for (int bj = 0; bj < 2; ++bj)
#pragma unroll
                    for (int e = 0; e < 8; ++e) { float s = cs[bj][e]; s += __shfl_xor(s, 1); s += __shfl_xor(s, 2); s += __shfl_xor(s, 4); s += __shfl_xor(s, 8); cs[bj][e] = s; }
                if (fr == 0) {
#pragma unroll
                    for (int bj = 0; bj < 2; ++bj)
#pragma unroll
                        for (int e = 0; e < 8; ++e) atomicAdd(kms + (size_t)u.pm * AW + ct + bj * HALF + cw + e, cs[bj][e]);
                }
            }
        } else {
            const int ct = (u.pn - 8) * 256;
#pragma unroll
            for (int ai = 0; ai < 2; ++ai)
#pragma unroll
                for (int m = 0; m < 4; ++m) {
                    const int row = row0 + ai * HALF + m * 16;
#pragma unroll
                    for (int bj = 0; bj < 2; ++bj) {
                        const f32x4 v0 = acc[ai][bj][m][0], v1 = acc[ai][bj][m][1];
                        u32x4 w; w.x = pkh(v0[0], v0[1]); w.y = pkh(v0[2], v0[3]); w.z = pkh(v1[0], v1[1]); w.w = pkh(v1[2], v1[3]);
                        *(u32x4*)(Vb + (size_t)row * AW + ct + bj * HALF + cw) = w;
                    }
                }
        }
    }
};
struct EpiF16 {
    static constexpr bool PERM = true, AFTER_DRAIN = false;
    f16_t* O; int ldc;
    __device__ __forceinline__ void operator()(const f32x4 (&acc)[2][2][4][2], const Unit& u, int wr, int wc, int fr_, int fq_) const {
        int t_ = threadIdx.x; asm volatile("" : "+v"(t_)); const int fr = t_ & 15, fq = (t_ >> 4) & 3;
        const int row0 = u.pm * BM + wr * 64 + fr; const int col0 = u.pn * BM + wc * 32 + 8 * fq;
#pragma unroll
        for (int ai = 0; ai < 2; ++ai)
#pragma unroll
            for (int m = 0; m < 4; ++m) { f16_t* rowp = O + (size_t)(row0 + ai * HALF + m * 16) * ldc + col0;
#pragma unroll
                for (int bj = 0; bj < 2; ++bj) { const f32x4 v0 = acc[ai][bj][m][0], v1 = acc[ai][bj][m][1];
                    u32x4 w; w.x = pkh(v0[0], v0[1]); w.y = pkh(v0[2], v0[3]); w.z = pkh(v1[0], v1[1]); w.w = pkh(v1[2], v1[3]);
                    *(u32x4*)(rowp + bj * HALF) = w; } }
    }
};
struct EpiRes {
    static constexpr bool PERM = false, AFTER_DRAIN = false;
    const float* base; float* out; f16_t* An; float* rowss;
    __device__ __forceinline__ void operator()(const f32x4 (&acc)[2][2][4][2], const Unit& u, int wr, int wc, int fr_, int fq_) const {
        int t_ = threadIdx.x; asm volatile("" : "+v"(t_)); const int fr = t_ & 15, fq = (t_ >> 4) & 3;
        const int col0 = u.pn * BM + wc * 32 + 4 * fq;
#pragma unroll
        for (int ai = 0; ai < 2; ++ai)
#pragma unroll
            for (int m = 0; m < 4; ++m) {
                const int r = u.pm * BM + ai * HALF + wr * 64 + m * 16 + fr; const size_t off = (size_t)r * D + col0;
                float ss = 0.f;
#pragma unroll
                for (int bj = 0; bj < 2; ++bj)
#pragma unroll
                    for (int n = 0; n < 2; ++n) {
                        const f32x4 bs = *(const f32x4*)(base + off + bj * HALF + n * 16);
                        const f32x4 o = bs + acc[ai][bj][m][n];
                        *(f32x4*)(out + off + bj * HALF + n * 16) = o;
                        ss += (o[0] * o[0] + o[1] * o[1]) + (o[2] * o[2] + o[3] * o[3]);
                        u32x2 w; w.x = pkh(o[0], o[1]); w.y = pkh(o[2], o[3]);
                        *(u32x2*)(An + off + bj * HALF + n * 16) = w;
                    }
                ss += __shfl_xor(ss, 16); ss += __shfl_xor(ss, 32);
                if (fq == 0) atomicAdd(rowss + r, ss);
            }
    }
};
struct EpiUp {
    static constexpr bool PERM = true, AFTER_DRAIN = false;
    f16_t* Hd; const float* rowss;
    __device__ __forceinline__ void operator()(const f32x4 (&acc)[2][2][4][2], const Unit& u, int wr, int wc, int fr_, int fq_) const {
        int t_ = threadIdx.x; asm volatile("" : "+v"(t_)); const int fr = t_ & 15, fq = (t_ >> 4) & 3;
        const int row0 = u.pm * BM + wr * 64 + fr; const int col0 = u.pn * HALF + wc * 32 + 8 * fq;
#pragma unroll
        for (int ai = 0; ai < 2; ++ai)
#pragma unroll
            for (int m = 0; m < 4; ++m) {
                const int row = row0 + ai * HALF + m * 16;
                const float rs = 1.0f / sqrtf(rowss[row] * (1.0f / D) + EPS);
                float h[8];
#pragma unroll
                for (int n = 0; n < 2; ++n)
#pragma unroll
                    for (int e = 0; e < 4; ++e) { const float g = acc[ai][0][m][n][e] * rs, up = acc[ai][1][m][n][e] * rs; h[4 * n + e] = g * sigmoidf_(g) * up; }
                u32x4 w; w.x = pkh(h[0], h[1]); w.y = pkh(h[2], h[3]); w.z = pkh(h[4], h[5]); w.w = pkh(h[6], h[7]);
                *(u32x4*)(Hd + (size_t)row * DFF + col0) = w;
            }
    }
};
struct EpiGate {
    static constexpr bool PERM = false, AFTER_DRAIN = false;
    float* out; const f16_t* PP; const float* rowss_in; float* rowss_out;
    __device__ __forceinline__ void operator()(const f32x4 (&acc)[2][2][4][2], const Unit& u, int wr, int wc, int fr_, int fq_) const {
        int t_ = threadIdx.x; asm volatile("" : "+v"(t_)); const int fr = t_ & 15, fq = (t_ >> 4) & 3;
        const int col0 = u.pn * BM + wc * 32 + 4 * fq;
#pragma unroll
        for (int ai = 0; ai < 2; ++ai)
#pragma unroll
            for (int m = 0; m < 4; ++m) {
                const int r = u.pm * BM + ai * HALF + wr * 64 + m * 16 + fr; const size_t off = (size_t)r * D + col0;
                const float rs = 1.0f / sqrtf(rowss_in[r] * (1.0f / D) + EPS);
                float ss = 0.f;
#pragma unroll
                for (int bj = 0; bj < 2; ++bj)
#pragma unroll
                    for (int n = 0; n < 2; ++n) {
                        const f32x4 bs = *(const f32x4*)(out + off + bj * HALF + n * 16);
                        const f16x4 pp = *(const f16x4*)(PP + off + bj * HALF + n * 16);
                        const f32x4 a = acc[ai][bj][m][n] * rs;
                        f32x4 o;
#pragma unroll
                        for (int e = 0; e < 4; ++e) o[e] = bs[e] + sigmoidf_(a[e]) * (float)pp[e];
                        *(f32x4*)(out + off + bj * HALF + n * 16) = o;
                        ss += (o[0] * o[0] + o[1] * o[1]) + (o[2] * o[2] + o[3] * o[3]);
                    }
                ss += __shfl_xor(ss, 16); ss += __shfl_xor(ss, 32);
                if (fq == 0) atomicAdd(rowss_out + r, ss);
            }
    }
};

template <class Epi, class Sched, bool ALIGN_EPI = false, bool SP2 = false>
__device__ __forceinline__ void gemm_phase(LAS unsigned char* lds, const Gemm g, const Sched& S, const Epi& E) {
    const int tid = threadIdx.x, wid = __builtin_amdgcn_readfirstlane(tid >> 6), lane = tid & 63, wr = wid >> 2, wc = wid & 3, fr = lane & 15, fq = lane >> 4;
    const int K = g.K, nt = K / BK;
    unsigned voffA[2], voffB[2];
#pragma unroll
    for (int i = 0; i < 2; ++i) { int R, C; stage_rc(tid * 16 + i * 8192, R, C); const int Rb = Epi::PERM ? ((R & ~31) + perm32(R & 31)) : R;
        voffA[i] = (unsigned)(R * K + C) * 2u; voffB[i] = (unsigned)(Rb * K + C) * 2u; }
    const size_t kstep = (size_t)(BK * 2);
    const size_t hstep = (size_t)HALF * K * 2;
    const size_t tstep = 2 * hstep;
    const unsigned ldsw = (unsigned)wid * 1024u;
    const unsigned ldsb = (unsigned)(uintptr_t)lds;
    const int aoff = lds_byte(wr * 64 + fr, fq * 8), boff = lds_byte(wc * 32 + fr, fq * 8);
#define PG8_SA(b, h) (((b) * 2 + (h)) * HTB)
#define PG8_SB(b, h) ((4 + (b) * 2 + (h)) * HTB)
#define PG8_STAGE(bufoff, gbase, voff) do { _Pragma("unroll") for (int _i = 0; _i < 2; ++_i) \
        glds16s((voff)[_i], (const void*)(gbase), (unsigned)__builtin_amdgcn_readfirstlane(ldsb + (unsigned)(bufoff) + ldsw + _i * 8192u)); } while (0)
#define PG8_LDA(dst, b, h) do { _Pragma("unroll") for (int m = 0; m < 4; ++m) _Pragma("unroll") for (int k = 0; k < 2; ++k) dst[m][k] = *(const LAS f16x8*)(lds + PG8_SA(b, h) + aoff + m * 2048 + k * 1024); } while (0)
#define PG8_LDB(dst, b, h) do { _Pragma("unroll") for (int n = 0; n < 2; ++n) _Pragma("unroll") for (int k = 0; k < 2; ++k) dst[n][k] = *(const LAS f16x8*)(lds + PG8_SB(b, h) + boff + n * 2048 + k * 1024); } while (0)
#define PG8_MMA(ai, bj, At, Bt) do { __builtin_amdgcn_s_setprio(1); _Pragma("unroll") for (int m = 0; m < 4; ++m) _Pragma("unroll") for (int n = 0; n < 2; ++n) _Pragma("unroll") for (int k = 0; k < 2; ++k) \
        acc[ai][bj][m][n] = __builtin_amdgcn_mfma_f32_16x16x32_f16(Bt[n][k], At[m][k], acc[ai][bj][m][n], 0, 0, 0); __builtin_amdgcn_s_setprio(0); } while (0)
#define PG8_WAIT_V(n) asm volatile("s_waitcnt vmcnt(" #n ")" ::: "memory")
#define PG8_WAIT_L(n) asm volatile("s_waitcnt lgkmcnt(" #n ")" ::: "memory")
#define PG8_BAR __builtin_amdgcn_s_barrier()
#define PG8_SCHED __builtin_amdgcn_sched_barrier(0)
    Unit cur, nxt; int ui = 0;
    if (!S.next(0, cur)) return;
    f32x4 acc[2][2][4][2];
#pragma unroll
    for (int a = 0; a < 2; ++a)
#pragma unroll
        for (int b = 0; b < 2; ++b)
#pragma unroll
            for (int m = 0; m < 4; ++m)
#pragma unroll
                for (int n = 0; n < 2; ++n) acc[a][b][m][n] = (f32x4){0.f, 0.f, 0.f, 0.f};
    f16x8 At[4][2], B0[2][2], B1[2][2];
    const char* cA = (const char*)g.A + (size_t)cur.pm * tstep; const char* cB = (const char*)g.Bt + (size_t)cur.pn * tstep;
    S.a_ready(cur);
    if constexpr (SP2) {
        PG8_STAGE(PG8_SB(0, 0), cB, voffB); PG8_STAGE(PG8_SB(0, 1), cB + hstep, voffB); PG8_STAGE(PG8_SA(0, 0), cA, voffA); PG8_STAGE(PG8_SA(0, 1), cA + hstep, voffA);
        if (wr == 1) PG8_BAR;
        PG8_WAIT_V(2); PG8_BAR;
        PG8_STAGE(PG8_SB(1, 0), cB + kstep, voffB); PG8_STAGE(PG8_SA(1, 0), cA + kstep, voffA); PG8_STAGE(PG8_SB(1, 1), cB + hstep + kstep, voffB);
        PG8_WAIT_V(6); PG8_BAR;
    } else {
        PG8_STAGE(PG8_SB(0, 0), cB, voffB); PG8_STAGE(PG8_SA(0, 0), cA, voffA); PG8_STAGE(PG8_SB(0, 1), cB + hstep, voffB); PG8_STAGE(PG8_SA(0, 1), cA + hstep, voffA);
        if (wr == 1) PG8_BAR;
        PG8_WAIT_V(4); PG8_BAR;
        PG8_STAGE(PG8_SB(1, 0), cB + kstep, voffB); PG8_STAGE(PG8_SA(1, 0), cA + kstep, voffA); PG8_STAGE(PG8_SB(1, 1), cB + hstep + kstep, voffB);
        PG8_WAIT_V(6); PG8_BAR;
    }
    for (;;) {
        const bool has_next = S.next(ui + 1, nxt);
        const char* nA = has_next ? (const char*)g.A + (size_t)nxt.pm * tstep : cA; const char* nB = has_next ? (const char*)g.Bt + (size_t)nxt.pn * tstep : cB;
        for (int t = 0; t < nt; t += 2) {
            const bool last = (t == nt - 2);
            const char* a1 = cA + (size_t)(t + 1) * kstep;
            const char* a2 = last ? nA : cA + (size_t)(t + 2) * kstep; const char* b2 = last ? nB : cB + (size_t)(t + 2) * kstep;
            const char* a3 = a2 + kstep; const char* b3 = b2 + kstep;
            if (last && has_next) S.a_ready(nxt);
            if constexpr (SP2) {
            PG8_LDB(B0, 0, 0); PG8_LDB(B1, 0, 1); PG8_SCHED; PG8_LDA(At, 0, 0); PG8_STAGE(PG8_SA(1, 1), a1 + hstep, voffA);
            PG8_WAIT_V(8); PG8_WAIT_L(0); PG8_BAR; PG8_MMA(0, 0, At, B0); PG8_MMA(0, 1, At, B1); PG8_BAR; PG8_SCHED;
            PG8_LDA(At, 0, 1); PG8_STAGE(PG8_SB(0, 0), b2, voffB); PG8_STAGE(PG8_SB(0, 1), b2 + hstep, voffB); PG8_STAGE(PG8_SA(0, 0), a2, voffA);
            PG8_WAIT_V(8); PG8_WAIT_L(0); PG8_BAR; PG8_MMA(1, 0, At, B0); PG8_MMA(1, 1, At, B1); PG8_BAR; PG8_SCHED;
            PG8_LDB(B0, 1, 0); PG8_LDB(B1, 1, 1); PG8_SCHED; PG8_LDA(At, 1, 0); PG8_STAGE(PG8_SA(0, 1), a2 + hstep, voffA);
            PG8_WAIT_V(8); PG8_WAIT_L(0); PG8_BAR; PG8_MMA(0, 0, At, B0); PG8_MMA(0, 1, At, B1); PG8_BAR; PG8_SCHED;
            PG8_LDA(At, 1, 1); PG8_STAGE(PG8_SB(1, 0), b3, voffB); PG8_STAGE(PG8_SB(1, 1), b3 + hstep, voffB); PG8_STAGE(PG8_SA(1, 0), a3, voffA);
            PG8_WAIT_V(8); PG8_WAIT_L(0); PG8_BAR; PG8_MMA(1, 0, At, B0); PG8_MMA(1, 1, At, B1); PG8_BAR; PG8_SCHED;
            } else {
            PG8_LDB(B0, 0, 0); PG8_SCHED; PG8_LDA(At, 0, 0); PG8_STAGE(PG8_SA(1, 1), a1 + hstep, voffA);
            PG8_WAIT_L(8); PG8_BAR; PG8_WAIT_L(0); PG8_MMA(0, 0, At, B0); PG8_BAR; PG8_SCHED;
            PG8_LDB(B1, 0, 1); PG8_STAGE(PG8_SB(0, 0), b2, voffB);
            PG8_BAR; PG8_WAIT_L(0); PG8_MMA(0, 1, At, B1); PG8_BAR;
            PG8_LDA(At, 0, 1); PG8_STAGE(PG8_SA(0, 0), a2, voffA);
            PG8_BAR; PG8_WAIT_L(0); PG8_MMA(1, 0, At, B0); PG8_BAR; PG8_SCHED;
            PG8_STAGE(PG8_SB(0, 1), b2 + hstep, voffB);
            PG8_WAIT_V(6); PG8_BAR; PG8_MMA(1, 1, At, B1); PG8_BAR;
            PG8_LDB(B0, 1, 0); PG8_SCHED; PG8_LDA(At, 1, 0); PG8_STAGE(PG8_SA(0, 1), a2 + hstep, voffA);
            PG8_WAIT_L(8); PG8_BAR; PG8_WAIT_L(0); PG8_MMA(0, 0, At, B0); PG8_BAR; PG8_SCHED;
            PG8_LDB(B1, 1, 1); PG8_STAGE(PG8_SB(1, 0), b3, voffB);
            PG8_BAR; PG8_WAIT_L(0); PG8_MMA(0, 1, At, B1); PG8_BAR;
            PG8_LDA(At, 1, 1); PG8_STAGE(PG8_SA(1, 0), a3, voffA);
            PG8_BAR; PG8_WAIT_L(0); PG8_MMA(1, 0, At, B0); PG8_BAR; PG8_SCHED;
            PG8_STAGE(PG8_SB(1, 1), b3 + hstep, voffB);
            PG8_WAIT_V(6); PG8_BAR; PG8_MMA(1, 1, At, B1); PG8_BAR;
            }
        }
        if constexpr (ALIGN_EPI) { if (wr == 0) PG8_BAR; }
        if constexpr (!Epi::AFTER_DRAIN) { E(acc, cur, wr, wc, fr, fq); S.done(cur); }
        if (!has_next) break;
#pragma unroll
        for (int a = 0; a < 2; ++a)
#pragma unroll
            for (int b = 0; b < 2; ++b)
#pragma unroll
                for (int m = 0; m < 4; ++m)
#pragma unroll
                    for (int n = 0; n < 2; ++n) acc[a][b][m][n] = (f32x4){0.f, 0.f, 0.f, 0.f};
        cur = nxt; cA = nA; cB = nB; ++ui;
        if constexpr (ALIGN_EPI) { if (wr == 1) PG8_BAR; }
    }
    PG8_WAIT_V(0);
    if constexpr (!ALIGN_EPI) { if (wr == 0) PG8_BAR; }
    PG8_BAR;
#undef PG8_SA
#undef PG8_SB
#undef PG8_STAGE
#undef PG8_LDA
#undef PG8_LDB
#undef PG8_MMA
#undef PG8_WAIT_V
#undef PG8_WAIT_L
#undef PG8_BAR
#undef PG8_SCHED
}
}

namespace attn_body {
constexpr int NW = 8, QBLK = 32, QB = QBLK * NW, KVBLK = 64;
constexpr int QP = D;
constexpr int KP = AW;
__device__ __forceinline__ int crow(int r, int hi) { return (r & 3) + 8 * (r >> 2) + 4 * hi; }
#define SBAR() __builtin_amdgcn_sched_barrier(0)
__device__ __forceinline__ void cmask(f32x16& p0, f32x16& p1, int jb, int qrel, int hi) {
    const float NEG = -INFINITY; int kb = 64 * jb + 4 * hi;
#pragma unroll
    for (int r = 0; r < 16; ++r) { int kv = kb + (r & 3) + 8 * (r >> 2); if (kv > qrel) p0[r] = NEG; if (kv + 32 > qrel) p1[r] = NEG; }
}
__device__ __forceinline__ void mmask(f32x16& p0, f32x16& p1, bool keep) {
    const float NEG = -INFINITY;
#pragma unroll
    for (int r = 0; r < 16; ++r) { p0[r] = keep ? p0[r] : NEG; p1[r] = keep ? p1[r] : NEG; }
}
constexpr int NSLOT = 3, SLOTB = 8192;
constexpr int LDS_K = 0, LDS_V = NSLOT * SLOTB, LDS_WS = 2 * NSLOT * SLOTB, LDS_OST = LDS_WS + NW * 64 * 4, LDS_BYTES = LDS_OST + NW * 4096;
__device__ __forceinline__ void glds16(const void* gsrc, unsigned lds_dst) { unsigned keep;
    asm volatile("s_mov_b32 %0, m0\n\ts_mov_b32 m0, %2\n\ts_nop 0\n\tglobal_load_lds_dwordx4 %1, off\n\ts_mov_b32 m0, %0" : "=&s"(keep) : "v"(gsrc), "s"(lds_dst) : "memory"); }
__device__ __forceinline__ float max3f(float a, float b, float c) { float r; asm("v_max3_f32 %0, %1, %2, %3" : "=v"(r) : "v"(a), "v"(b), "v"(c)); return r; }
__device__ __forceinline__ float max2f(float a, float b) { float r; asm("v_max_f32_e32 %0, %1, %2" : "=v"(r) : "v"(a), "v"(b)); return r; }
__device__ __forceinline__ float fadd_s(float a, float b) { float r; asm("v_add_f32_e32 %0, %1, %2" : "=v"(r) : "v"(a), "v"(b)); return r; }
__device__ __forceinline__ float fsub_s(float a, float b) { float r; asm("v_sub_f32_e32 %0, %1, %2" : "=v"(r) : "v"(a), "v"(b)); return r; }
#define WAIT_BAR(N) asm volatile("s_waitcnt vmcnt(" #N ") lgkmcnt(0)\n\ts_barrier" ::: "memory")

__device__ __forceinline__ void qkt(f32x16& p0, f32x16& p1, const char* Kslot, const f16x8* qr, const f32x16& negm, int r32, int hi) {
    const char* kb = Kslot + hi * 1024 + r32 * 16;
#pragma unroll
    for (int d0 = 0; d0 < 4; ++d0) {
        const f16x8 b0 = *reinterpret_cast<const f16x8*>(kb + d0 * 2048);
        const f16x8 b1 = *reinterpret_cast<const f16x8*>(kb + d0 * 2048 + 512);
        if (d0 == 0) { p0 = __builtin_amdgcn_mfma_f32_32x32x16_f16(b0, qr[0], negm, 0, 0, 0); p1 = __builtin_amdgcn_mfma_f32_32x32x16_f16(b1, qr[0], negm, 0, 0, 0); }
        else { p0 = __builtin_amdgcn_mfma_f32_32x32x16_f16(b0, qr[d0], p0, 0, 0, 0); p1 = __builtin_amdgcn_mfma_f32_32x32x16_f16(b1, qr[d0], p1, 0, 0, 0); } }
}
typedef __attribute__((address_space(3))) const char* lds_cptr;
typedef short v4i16_t __attribute__((ext_vector_type(4)));
__device__ __forceinline__ void kload8(f16x8* kf, lds_cptr kp) {
    kf[0] = *(const LAS f16x8*)(kp);        kf[1] = *(const LAS f16x8*)(kp + 512);
    kf[2] = *(const LAS f16x8*)(kp + 2048); kf[3] = *(const LAS f16x8*)(kp + 2560);
    kf[4] = *(const LAS f16x8*)(kp + 4096); kf[5] = *(const LAS f16x8*)(kp + 4608);
    kf[6] = *(const LAS f16x8*)(kp + 6144); kf[7] = *(const LAS f16x8*)(kp + 6656);
}
__device__ __forceinline__ void kload2(f16x8* kf, lds_cptr kp, int j) { kf[2 * j] = *(const LAS f16x8*)(kp + j * 2048); kf[2 * j + 1] = *(const LAS f16x8*)(kp + j * 2048 + 512); }
__device__ __forceinline__ f16x4 vtr(lds_cptr p) { return __builtin_bit_cast(f16x4, __builtin_amdgcn_ds_read_tr16_b64_v4i16((LAS v4i16_t*)p)); }
__device__ __forceinline__ float rowmax(const f32x16& p0, const f32x16& p1) {
    float a = max3f(p0[0], p0[1], p1[0]), b = max3f(p0[2], p0[3], p1[1]); a = max3f(a, p1[2], p1[3]);
#pragma unroll
    for (int r = 4; r < 16; r += 4) { a = max3f(a, p0[r], p0[r + 1]); b = max3f(b, p0[r + 2], p0[r + 3]); a = max3f(a, p1[r], p1[r + 1]); b = max3f(b, p1[r + 2], p1[r + 3]); }
    const float m = max2f(a, b);
    auto rr = __builtin_amdgcn_permlane32_swap(__float_as_uint(m), __float_as_uint(m), false, false);
    return max2f(__uint_as_float(rr[0]), __uint_as_float(rr[1]));
}
__device__ __forceinline__ void pv(f32x16* o, int vb, f16x8 pa0, f16x8 pa1, f16x8 pa2, f16x8 pa3) {
#pragma unroll
    for (int d0 = 0; d0 < 2; ++d0) { f16x4 lo[4], hi[4];
#pragma unroll
        for (int ks = 0; ks < 4; ++ks) {
            asm volatile("ds_read_b64_tr_b16 %0,%1 offset:%c2" : "=&v"(lo[ks]) : "v"(vb), "i"(d0 * 4096 + ks * 1024) : "memory");
            asm volatile("ds_read_b64_tr_b16 %0,%1 offset:%c2" : "=&v"(hi[ks]) : "v"(vb), "i"(d0 * 4096 + ks * 1024 + 512) : "memory"); }
        asm volatile("s_waitcnt lgkmcnt(0)" ::: "memory"); SBAR();
#define PK(k) __builtin_shufflevector(lo[k], hi[k], 0, 1, 2, 3, 4, 5, 6, 7)
        o[d0] = __builtin_amdgcn_mfma_f32_32x32x16_f16(pa0, PK(0), o[d0], 0, 0, 0);
        o[d0] = __builtin_amdgcn_mfma_f32_32x32x16_f16(pa1, PK(1), o[d0], 0, 0, 0);
        o[d0] = __builtin_amdgcn_mfma_f32_32x32x16_f16(pa2, PK(2), o[d0], 0, 0, 0);
        o[d0] = __builtin_amdgcn_mfma_f32_32x32x16_f16(pa3, PK(3), o[d0], 0, 0, 0);
#undef PK
    }
}

__device__ __forceinline__ unsigned moba_select(int b, int h, int qb, const f16_t* Q, const float* __restrict__ kms) {
    int tid_ = threadIdx.x; asm volatile("" : "+v"(tid_));
    const int tid = tid_, lane = tid & 63, r32 = lane & 31, hi = lane >> 5; const int wid = __builtin_amdgcn_readfirstlane(tid >> 6);
    const f16_t* Qw = Q + ((long)b * SEQ + qb * QB + wid * QBLK) * QP + h * HD;
    f16x8 qr[4];
#pragma unroll
    for (int d0 = 0; d0 < 4; ++d0) qr[d0] = *reinterpret_cast<const f16x8*>(&Qw[(long)r32 * QP + d0 * 16 + hi * 8]);
    float gsc[7];
#pragma unroll
    for (int j = 0; j < 7; ++j) {
        float s = 0.f;
        if (j < qb) {
            const float* km = kms + (size_t)(b * NBLK + j) * AW + h * HD + hi * 8;
#pragma unroll
            for (int d0 = 0; d0 < 4; ++d0) {
                const f32x4 k0 = *(const f32x4*)(km + d0 * 16), k1 = *(const f32x4*)(km + d0 * 16 + 4);
                s += (float)qr[d0][0] * k0[0] + (float)qr[d0][1] * k0[1] + (float)qr[d0][2] * k0[2] + (float)qr[d0][3] * k0[3];
                s += (float)qr[d0][4] * k1[0] + (float)qr[d0][5] * k1[1] + (float)qr[d0][6] * k1[2] + (float)qr[d0][7] * k1[3];
            }
            s += __shfl_xor(s, 32);
            asm volatile("" ::: "memory");
        } else s = -INFINITY;
        gsc[j] = s;
    }
    unsigned sm = 0u;
#pragma unroll
    for (int j = 0; j < 7; ++j) {
        int cnt = 0;
#pragma unroll
        for (int i = 0; i < 7; ++i) { if (i == j) continue; const bool ahead = (gsc[i] > gsc[j]) || (gsc[i] == gsc[j] && i < j); cnt += ahead ? 1 : 0; }
        if (j < qb && cnt < 3) sm |= (1u << j);
    }
    return sm;
}

template <int THRL> __device__ __forceinline__ void attn_unit(int b, int h, int qb, const f16_t* Q, const f16_t* __restrict__ K, const f16_t* __restrict__ V, f16_t* O, const unsigned selmask, char* shm) {
    int tid_ = threadIdx.x; asm volatile("" : "+v"(tid_));
    const int tid = tid_, lane = tid & 63, r32 = lane & 31, hi = lane >> 5; const int wid = __builtin_amdgcn_readfirstlane(tid >> 6);
    const long rowbase = (long)b * SEQ; const int q0 = qb * QB;
    const f16_t* Qw = Q + (rowbase + q0 + wid * QBLK) * QP + h * HD;
    const f16_t* Kh = K + rowbase * KP + h * HD, *Vh = V + rowbase * KP + h * HD;
    const unsigned lds0 = (unsigned)(uintptr_t)shm;
    float* wsf = (float*)(shm + LDS_WS) + wid * 64;
    const f16_t* ksrc = Kh + (long)lane * KP + wid * 8;
    const f16_t* vsrc = Vh + (long)(16 * (wid & 3) + (lane >> 2)) * KP + (wid >> 2) * 32 + (lane & 3) * 8;
    const unsigned kdst = lds0 + LDS_K + wid * 1024, vdst = lds0 + LDS_V + wid * 1024;
#define DMA_K(t, slot) glds16(ksrc + (long)(t) * KVBLK * KP, (unsigned)__builtin_amdgcn_readfirstlane(kdst + (slot)))
#define DMA_V(t, slot) glds16(vsrc + (long)(t) * KVBLK * KP, (unsigned)__builtin_amdgcn_readfirstlane(vdst + (slot)))
    const int vb0 = (int)(lds0 + LDS_V) + ((lane >> 4) & 1) * 32 + (lane & 3) * 8 + (4 * hi + ((lane & 15) >> 2)) * 64;
    const char* Kbase = shm + LDS_K; f16x8 kf[8];
    const lds_cptr shm3 = (lds_cptr)shm; const lds_cptr kp0 = shm3 + LDS_K + hi * 1024 + r32 * 16; const lds_cptr vp0 = shm3 + LDS_V + ((lane >> 4) & 1) * 32 + (lane & 3) * 8 + (4 * hi + ((lane & 15) >> 2)) * 64;
    const int NT = (q0 + QB) / KVBLK;
    DMA_K(0, 0); DMA_V(0, 0); DMA_K(1, SLOTB);
    f16x8 qr[4];
#pragma unroll
    for (int d0 = 0; d0 < 4; ++d0) qr[d0] = *reinterpret_cast<const f16x8*>(&Qw[(long)r32 * QP + d0 * 16 + hi * 8]);
    const bool maskon = qb > 3;
    float mhat = 0.f, l_reg = 0.f; float z_; asm volatile("v_mov_b32 %0, 0" : "=v"(z_)); f32x16 o[2]; f32x16 negm;
    _Pragma("unroll") for (int r = 0; r < 16; ++r) { o[0][r] = z_; o[1][r] = z_; negm[r] = z_; } asm volatile("" : "+v"(negm));
#define CMASK(P0, P1, t) do { int jb_ = (t) - (NT - 4); if (jb_ >= 0) { int q_ = r32; asm volatile("" : "+v"(q_)); cmask(P0, P1, jb_, wid * QBLK + q_, hi); } else if (maskon) mmask(P0, P1, ((selmask >> ((t) >> 2)) & 1u) != 0u); } while (0)
    bool resc = false;
#define START(P0, P1) do { const float rm = rowmax(P0, P1); resc = false; \
    { const float dl = max2f(rm, -100.f); mhat = fadd_s(mhat, dl); \
      _Pragma("unroll") for (int r = 0; r < 16; ++r) { P0[r] = fsub_s(P0[r], dl); P1[r] = fsub_s(P1[r], dl); } \
      _Pragma("unroll") for (int r = 0; r < 16; ++r) negm[r] = -mhat; asm volatile("" : "+v"(negm)); } \
    _Pragma("unroll") for (int r = 0; r < 16; ++r) P0[r] = __builtin_amdgcn_exp2f(P0[r]); } while (0)
#define RESC() do { if (resc) { asm volatile("s_waitcnt lgkmcnt(0)" ::: "memory"); \
      _Pragma("unroll") for (int d_ = 0; d_ < 2; ++d_) _Pragma("unroll") for (int r = 0; r < 16; ++r) o[d_][r] *= wsf[crow(r, hi)]; } } while (0)
    f32x16 pA0, pA1, pB0, pB1;
    int sl_prev = 0, sl_cur = 0, sl_next = SLOTB;
#define ROT() do { sl_prev = sl_cur; sl_cur = sl_next; sl_next = (sl_next == (NSLOT - 1) * SLOTB) ? 0 : sl_next + SLOTB; } while (0)
    DMA_K(2, 2 * SLOTB);
    WAIT_BAR(3);
    qkt(pA0, pA1, Kbase, qr, negm, r32, hi); asm volatile("s_nop 15\n\ts_nop 7" : "+v"(pA0), "+v"(pA1)); CMASK(pA0, pA1, 0);
    START(pA0, pA1);
    _Pragma("unroll") for (int r = 0; r < 16; ++r) pA1[r] = __builtin_amdgcn_exp2f(pA1[r]);
    WAIT_BAR(0);
    DMA_K(3, 0); DMA_V(1, SLOTB);
    ROT();
    kload8(kf, kp0 + sl_cur);
    WAIT_BAR(2);
    f16x4 vlo[8], vhi[8]; u32x4 pw0, pw1, pw2, pw3;
#define PKW(P, B) pkh(P[B], P[B + 1])
#define PAF(k) __builtin_bit_cast(f16x8, pw##k)
#define VFR(i) __builtin_shufflevector(vlo[i], vhi[i], 0, 1, 2, 3, 4, 5, 6, 7)
#define PIN(x) asm volatile("" : "+v"(x))
#define MX3(a, b, c) __builtin_fmaxf(__builtin_fmaxf((a), (b)), (c))
#define GAPA(MF, A0, A1, A2, A3, W0, W1, PW) do { MF; sacc += A0; sacc += A1; sacc += A2; sacc += A3; PIN(sacc); W0; W1; PIN(PW); SBAR(); } while (0)
#define EX(v) __builtin_amdgcn_exp2f(v)
#define GAPB(MF, X, B) do { MF; X[B] = EX(X[B]); X[B + 1] = EX(X[B + 1]); X[B + 2] = EX(X[B + 2]); X[B + 3] = EX(X[B + 3]); PIN(X); SBAR(); } while (0)
#define VRD(i) do { vlo[i] = vtr(vp_ + (((i) >> 2) * 4096 + ((i) & 3) * 1024)); vhi[i] = vtr(vp_ + (((i) >> 2) * 4096 + ((i) & 3) * 1024 + 512)); } while (0)
#define KRD(G, j) do { if (G) { kload2(kf, kp0 + sl_next, j); SBAR(); } } while (0)
#define MF16(a, b, c) __builtin_amdgcn_mfma_f32_32x32x16_f16(a, b, c, 0, 0, 0)
#define STEP(C0, C1, P0, P1, t, GK, GV, GL) do { SBAR(); \
    const lds_cptr vp_ = vp0 + sl_prev; \
    VRD(0); SBAR(); float sacc = (P0[0] + P0[1]); \
    GAPA(C0 = MF16(kf[0], qr[0], negm), P0[2], P0[3], P0[4], P0[5],     pw0[0] = PKW(P0, 0), pw0[1] = PKW(P0, 2), pw0); \
    VRD(4); SBAR(); GAPA(C1 = MF16(kf[1], qr[0], negm), P0[6], P0[7], P0[8], P0[9],     pw0[2] = PKW(P0, 4), pw0[3] = PKW(P0, 6), pw0); \
    VRD(1); SBAR(); GAPA(C0 = MF16(kf[2], qr[1], C0),   P0[10], P0[11], P0[12], P0[13], pw1[0] = PKW(P0, 8), pw1[1] = PKW(P0, 10), pw1); \
    VRD(5); SBAR(); GAPA(C1 = MF16(kf[3], qr[1], C1),   P0[14], P0[15], P1[0], P1[1],   pw1[2] = PKW(P0, 12), pw1[3] = PKW(P0, 14), pw1); \
    VRD(2); SBAR(); GAPA(C0 = MF16(kf[4], qr[2], C0),   P1[2], P1[3], P1[4], P1[5],     pw2[0] = PKW(P1, 0), pw2[1] = PKW(P1, 2), pw2); \
    VRD(6); SBAR(); GAPA(C1 = MF16(kf[5], qr[2], C1),   P1[6], P1[7], P1[8], P1[9],     pw2[2] = PKW(P1, 4), pw2[3] = PKW(P1, 6), pw2); \
    VRD(3); SBAR(); GAPA(C0 = MF16(kf[6], qr[3], C0),   P1[10], P1[11], P1[12], P1[13], pw3[0] = PKW(P1, 8), pw3[1] = PKW(P1, 10), pw3); \
    VRD(7); SBAR(); GAPA(C1 = MF16(kf[7], qr[3], C1),   P1[14], P1[15], 0.f, 0.f,       pw3[2] = PKW(P1, 12), pw3[3] = PKW(P1, 14), pw3); \
    l_reg += sacc; \
    if (GK) { DMA_K((t) + 3, sl_cur); } if (GV) { DMA_V((t) + 1, sl_next); } \
    CMASK(C0, C1, t); \
    { float a = MX3(C0[0], C0[1], C1[0]), b_ = MX3(C0[2], C0[3], C1[1]); a = MX3(a, C1[2], C1[3]); \
      _Pragma("unroll") for (int r = 4; r < 16; r += 4) { a = MX3(a, C0[r], C0[r + 1]); b_ = MX3(b_, C0[r + 2], C0[r + 3]); a = MX3(a, C1[r], C1[r + 1]); b_ = MX3(b_, C1[r + 2], C1[r + 3]); } \
      float rm = __builtin_fmaxf(a, b_); { auto rr = __builtin_amdgcn_permlane32_swap(__float_as_uint(rm), __float_as_uint(rm), false, false); rm = __builtin_fmaxf(__uint_as_float(rr[0]), __uint_as_float(rr[1])); } \
      resc = false; \
      if (__builtin_expect(__any(rm > (float)THRL), 0)) { const float dl = __builtin_fmaxf(rm, 0.f); mhat += dl; \
        _Pragma("unroll") for (int r = 0; r < 16; ++r) { C0[r] -= dl; C1[r] -= dl; } \
        _Pragma("unroll") for (int r = 0; r < 16; ++r) negm[r] = -mhat; asm volatile("" : "+v"(negm)); \
        const float f = __builtin_amdgcn_exp2f(-dl); l_reg *= f; if (hi == 0) wsf[r32] = f; resc = true; } } \
    SBAR(); \
    GAPB(o[0] = MF16(PAF(0), VFR(0), o[0]), C0, 0); \
    GAPB(o[1] = MF16(PAF(0), VFR(4), o[1]), C0, 4); \
    KRD(GL, 0); GAPB(o[0] = MF16(PAF(1), VFR(1), o[0]), C0, 8); \
    KRD(GL, 1); GAPB(o[1] = MF16(PAF(1), VFR(5), o[1]), C0, 12); \
    KRD(GL, 2); GAPB(o[0] = MF16(PAF(2), VFR(2), o[0]), C1, 0); \
    KRD(GL, 3); GAPB(o[1] = MF16(PAF(2), VFR(6), o[1]), C1, 4); \
    GAPB(o[0] = MF16(PAF(3), VFR(3), o[0]), C1, 8); \
    GAPB(o[1] = MF16(PAF(3), VFR(7), o[1]), C1, 12); \
    } while (0)
    int t = 1;
    for (; t + 5 < NT; t += 2) {
        STEP(pB0, pB1, pA0, pA1, t, true, true, true);     WAIT_BAR(2); RESC(); ROT();
        STEP(pA0, pA1, pB0, pB1, t + 1, true, true, true); WAIT_BAR(2); RESC(); ROT();
    }
#define ENDW(tt) do { if ((tt) + 3 < NT) { WAIT_BAR(2); } else if ((tt) + 2 < NT) { WAIT_BAR(1); } else { WAIT_BAR(0); } } while (0)
    for (; t + 1 < NT; t += 2) {
        STEP(pB0, pB1, pA0, pA1, t, (t + 3 < NT), (t + 1 < NT), (t + 1 < NT));         ENDW(t);     RESC(); ROT();
        STEP(pA0, pA1, pB0, pB1, t + 1, (t + 4 < NT), (t + 2 < NT), (t + 2 < NT));     ENDW(t + 1); RESC(); ROT();
    }
    STEP(pB0, pB1, pA0, pA1, NT - 1, false, false, false); RESC();
    { float sacc = pB0[0] + pB0[1]; _Pragma("unroll") for (int r = 2; r < 16; ++r) sacc += pB0[r]; _Pragma("unroll") for (int r = 0; r < 16; ++r) sacc += pB1[r]; l_reg += sacc;
      pw0 = (u32x4){PKW(pB0, 0), PKW(pB0, 2), PKW(pB0, 4), PKW(pB0, 6)}; pw1 = (u32x4){PKW(pB0, 8), PKW(pB0, 10), PKW(pB0, 12), PKW(pB0, 14)}; pw2 = (u32x4){PKW(pB1, 0), PKW(pB1, 2), PKW(pB1, 4), PKW(pB1, 6)}; pw3 = (u32x4){PKW(pB1, 8), PKW(pB1, 10), PKW(pB1, 12), PKW(pB1, 14)};
      SBAR(); pv(o, vb0 + sl_cur, PAF(0), PAF(1), PAF(2), PAF(3)); }
#undef PKW
#undef PAF
#undef VFR
#undef PIN
#undef MX3
#undef GAPA
#undef GAPB
#undef EX
#undef VRD
#undef KRD
#undef STEP
#undef ENDW
#undef MF16
    { auto rr = __builtin_amdgcn_permlane32_swap(__float_as_uint(l_reg), __float_as_uint(l_reg), false, false); l_reg = __uint_as_float(rr[0]) + __uint_as_float(rr[1]); }
    if (hi == 0) wsf[32 + r32] = l_reg; asm volatile("s_waitcnt lgkmcnt(0)" ::: "memory");
    float rli[16];
#pragma unroll
    for (int r = 0; r < 16; ++r) rli[r] = __builtin_amdgcn_rcpf(wsf[32 + crow(r, hi)]);
    f16_t* Ow = O + (rowbase + q0 + wid * QBLK) * QP + h * HD;
    { f16_t* stg = (f16_t*)(shm + LDS_OST) + wid * 2048;
#pragma unroll
      for (int r = 0; r < 16; ++r) { const int orow = crow(r, hi);
#pragma unroll
        for (int d0 = 0; d0 < 2; ++d0) stg[orow * 64 + d0 * 32 + r32] = (f16_t)(o[d0][r] * rli[r]); }
      asm volatile("s_waitcnt lgkmcnt(0)" ::: "memory");
#pragma unroll
      for (int i = 0; i < 4; ++i) { const int row = i * 8 + (lane >> 3), ch = lane & 7; const u32x4 v = *(const u32x4*)(stg + row * 64 + ch * 8); *(u32x4*)(Ow + (long)row * QP + ch * 8) = v; } }
    asm volatile("s_waitcnt lgkmcnt(0)\n\ts_barrier" ::: "memory");
#undef DMA_K
#undef DMA_V
#undef CMASK
#undef START
#undef RESC
#undef ROT
}
#undef SBAR
#undef WAIT_BAR
}

constexpr int NWAVES = 8;
constexpr size_t MiB = 1u << 20;
constexpr size_t WS_CTL = 0, CTL_ZERO_BYTES = 1 * MiB;
constexpr size_t WS_WIN = 1 * MiB, WS_WOUT = 6 * MiB, WS_WUP = 8 * MiB, WS_WDN = 19 * MiB, WS_WPG = 25 * MiB, WS_WPP = 27 * MiB;
constexpr size_t WS_ROPE = 28 * MiB;
constexpr size_t WS_XN = 29 * MiB;
constexpr size_t WS_PP = 61 * MiB;
constexpr size_t WS_HID = 93 * MiB;
constexpr size_t WS_P16 = 93 * MiB, WS_U = 101 * MiB, WS_K = 117 * MiB, WS_V = 133 * MiB, WS_MIX = 149 * MiB, WS_END = 181 * MiB;
static_assert(WS_HID + (size_t)M * DFF * 2 <= WS_END && WS_MIX + (size_t)M * D * 2 <= WS_END, "ws map");
constexpr size_t CTL_BAR = 16384;
constexpr size_t CTL_KMS = 64 * 1024;
constexpr size_t CTL_RSS1 = 256 * 1024, CTL_RSS2 = 320 * 1024, CTL_RSS3 = 384 * 1024;
constexpr int RING_OFF = 0, RING_BYTES = 131072;
constexpr int LDSCTL_OFF = RING_BYTES, MISC_OFF = LDSCTL_OFF + 320;
constexpr int LDS_BYTES = 147456;
static_assert(attn_body::LDS_BYTES <= RING_BYTES, "attention LDS");

__device__ __forceinline__ float wave_sum(float v) {
#pragma unroll
    for (int o = 1; o < 64; o <<= 1) v += __shfl_xor(v, o);
    return v;
}

struct Args { const void* in[17]; float* out; unsigned char* ws; int ph_lo, ph_hi; };

__device__ __forceinline__ void p0_transpose_item(const float* W, int K, int N, f16_t* WT, const float* gain, LAS float* scr, int k0, int n0, int drow0, int lane) {
#pragma unroll 8
    for (int i = 0; i < 32; ++i) { const int kk = 2 * i + (lane >> 5); float v = W[(size_t)(k0 + kk) * N + n0 + (lane & 31)]; if (gain) v *= gain[k0 + kk]; scr[kk * 33 + (lane & 31)] = v; }
    asm volatile("s_waitcnt lgkmcnt(0)" ::: "memory");
    const int c = lane & 7;
#pragma unroll
    for (int j = 0; j < 4; ++j) { const int n = (lane >> 3) + 8 * j; const LAS float* s = scr + (8 * c) * 33 + n;
        u32x4 o; o.x = pkh(s[0 * 33], s[1 * 33]); o.y = pkh(s[2 * 33], s[3 * 33]); o.z = pkh(s[4 * 33], s[5 * 33]); o.w = pkh(s[6 * 33], s[7 * 33]);
        *(u32x4*)(WT + (size_t)(drow0 + n) * K + k0 + 8 * c) = o; }
    asm volatile("s_waitcnt lgkmcnt(0)" ::: "memory");
}
__device__ __forceinline__ int glu_row(int n, int half) { const int s = n >= half ? 1 : 0; const int j = n - s * half; return 256 * (j >> 7) + 128 * s + (j & 127); }

__device__ __forceinline__ void sincos_d(double a, float& sn, float& cs) {
    const double q = __builtin_rint(a * 0.63661977236758134308);
    double r = __builtin_fma(-q, 1.57079632679489655800e+00, a); r = __builtin_fma(-q, 6.12323399573676603587e-17, r);
    const double r2 = r * r;
    double s = -7.6471637318198164759e-13; s = s * r2 + 1.6059043836821614599e-10; s = s * r2 - 2.5052108385441718775e-08; s = s * r2 + 2.7557319223985890653e-06;
    s = s * r2 - 1.9841269841269841270e-04; s = s * r2 + 8.3333333333333333333e-03; s = s * r2 - 1.6666666666666666667e-01; s = s * r2 * r + r;
    double c = 4.7794773323873852974e-14; c = c * r2 - 1.1470745597729724714e-11; c = c * r2 + 2.0876756987868098979e-09; c = c * r2 - 2.7557319223985890653e-07;
    c = c * r2 + 2.4801587301587301587e-05; c = c * r2 - 1.3888888888888888889e-03; c = c * r2 + 4.1666666666666666667e-02; c = c * r2 - 0.5; c = c * r2 + 1.0;
    const int qi = (int)(long long)q & 3;
    const double ss = (qi == 0) ? s : (qi == 1) ? c : (qi == 2) ? -s : -c;
    const double cc = (qi == 0) ? c : (qi == 1) ? -s : (qi == 2) ? -c : s;
    sn = (float)ss; cs = (float)cc;
}

__global__ void __launch_bounds__(NWAVES * 64, 2) fwd_kernel(Args args) {
    extern __shared__ __attribute__((aligned(16))) unsigned char lds_raw[];
    LAS unsigned char* lds = (LAS unsigned char*)lds_raw;
    const int tid = threadIdx.x, wave = __builtin_amdgcn_readfirstlane(tid >> 6);
    const int G = gridDim.x, bx = blockIdx.x;
    const int vcu = (G % 8 == 0) ? (bx % 8) * (G / 8) + bx / 8 : bx;
    unsigned char* ws = args.ws;
    const float* x = (const float*)args.in[0]; const float* p = (const float*)args.in[1]; const int* positions = (const int*)args.in[2];
    const float* norm_mix_g = (const float*)args.in[3]; const float* w_in = (const float*)args.in[4]; const float* conv_w = (const float*)args.in[5];
    const float* conv_b = (const float*)args.in[6]; const float* conv_ln_g = (const float*)args.in[7]; const float* conv_ln_b = (const float*)args.in[8];
    const float* w_out = (const float*)args.in[9]; const float* norm_ffn_g = (const float*)args.in[10]; const float* w_ffn_up = (const float*)args.in[11];
    const float* w_ffn_down = (const float*)args.in[12]; const float* norm_ple_g = (const float*)args.in[13]; const float* w_ple_gate = (const float*)args.in[14];
    const float* w_ple_proj = (const float*)args.in[15]; const float* final_norm_g = (const float*)args.in[16];
    float* out = args.out;
    f16_t* Win_t = (f16_t*)(ws + WS_WIN); f16_t* Wout_t = (f16_t*)(ws + WS_WOUT); f16_t* Wup_t = (f16_t*)(ws + WS_WUP); f16_t* Wdn_t = (f16_t*)(ws + WS_WDN);
    f16_t* Wpg_t = (f16_t*)(ws + WS_WPG); f16_t* Wpp_t = (f16_t*)(ws + WS_WPP);
    float* ropec = (float*)(ws + WS_ROPE); float* ropes = (float*)(ws + WS_ROPE + 512 * 1024);
    f16_t* XN = (f16_t*)(ws + WS_XN); f16_t* PP = (f16_t*)(ws + WS_PP); f16_t* HID = (f16_t*)(ws + WS_HID);
    f16_t* P16 = (f16_t*)(ws + WS_P16); f16_t* Ub = (f16_t*)(ws + WS_U); f16_t* Kb = (f16_t*)(ws + WS_K); f16_t* Vb = (f16_t*)(ws + WS_V); f16_t* MIX = (f16_t*)(ws + WS_MIX);
    float* kms = (float*)(ws + WS_CTL + CTL_KMS); float* rss1 = (float*)(ws + WS_CTL + CTL_RSS1); float* rss2 = (float*)(ws + WS_CTL + CTL_RSS2); float* rss3 = (float*)(ws + WS_CTL + CTL_RSS3);

    cg::grid_group grid = cg::this_grid();
    const int lo = args.ph_lo, hi = args.ph_hi;
#ifndef PHASES
#define PHASES 0xFF
#endif
#define IN(k) ((((PHASES) >> (k)) & 1) && lo <= (k) && (k) < hi)
#define SEAM(k) do { if (IN(k) && IN((k) + 1)) { grid.sync(); } } while (0)
    const int gw = vcu * NWAVES + wave, NGW = G * NWAVES;

    if (IN(0)) {
        const int lane = tid & 63;
        LAS float* scr = (LAS float*)(lds + RING_OFF + wave * 16384);
        constexpr int I_IN = (D / 64) * (INW / 32), I_OUT = (D / 64) * (D / 32), I_UP = (D / 64) * (2 * DFF / 32), I_DN = (DFF / 64) * (D / 32), I_PG = I_OUT, I_PP = (PLE / 64) * (D / 32);
        constexpr int NITEMS = I_IN + I_OUT + I_UP + I_DN + I_PG + I_PP;
        for (int it = gw; it < NITEMS; it += NGW) {
            int r = it;
            if (r < I_IN) { const int nblk = INW / 32, kb = r / nblk, nb = r % nblk, n0 = 32 * nb; const int drow = n0 < 2 * CONV_CH ? glu_row(n0, CONV_CH) : n0;
                p0_transpose_item(w_in, D, INW, Win_t, norm_mix_g, scr, 64 * kb, n0, drow, lane); continue; } r -= I_IN;
            if (r < I_OUT) { const int nblk = D / 32, kb = r / nblk, nb = r % nblk; p0_transpose_item(w_out, D, D, Wout_t, nullptr, scr, 64 * kb, 32 * nb, 32 * nb, lane); continue; } r -= I_OUT;
            if (r < I_UP) { const int nblk = 2 * DFF / 32, kb = r / nblk, nb = r % nblk, n0 = 32 * nb; p0_transpose_item(w_ffn_up, D, 2 * DFF, Wup_t, norm_ffn_g, scr, 64 * kb, n0, glu_row(n0, DFF), lane); continue; } r -= I_UP;
            if (r < I_DN) { const int nblk = D / 32, kb = r / nblk, nb = r % nblk; p0_transpose_item(w_ffn_down, DFF, D, Wdn_t, nullptr, scr, 64 * kb, 32 * nb, 32 * nb, lane); continue; } r -= I_DN;
            if (r < I_PG) { const int nblk = D / 32, kb = r / nblk, nb = r % nblk; p0_transpose_item(w_ple_gate, D, D, Wpg_t, norm_ple_g, scr, 64 * kb, 32 * nb, 32 * nb, lane); continue; } r -= I_PG;
            { const int nblk = D / 32, kb = r / nblk, nb = r % nblk; p0_transpose_item(w_ple_proj, PLE, D, Wpp_t, nullptr, scr, 64 * kb, 32 * nb, 32 * nb, lane); }
        }
        for (int m = gw; m < M; m += NGW) {
            const f32x4* xr = (const f32x4*)(x + (size_t)m * D) + lane;
            f32x4 v[4]; float s2 = 0.f;
#pragma unroll
            for (int j = 0; j < 4; ++j) { v[j] = xr[64 * j]; s2 += (v[j][0] * v[j][0] + v[j][1] * v[j][1]) + (v[j][2] * v[j][2] + v[j][3] * v[j][3]); }
            const float rstd = 1.0f / sqrtf(wave_sum(s2) * (1.0f / D) + EPS);
            u32x2* o8 = (u32x2*)(XN + (size_t)m * D) + lane;
#pragma unroll
            for (int j = 0; j < 4; ++j) { u32x2 w; w.x = pkh(v[j][0] * rstd, v[j][1] * rstd); w.y = pkh(v[j][2] * rstd, v[j][3] * rstd); o8[64 * j] = w; }
        }
        for (size_t i = (size_t)(vcu * 512 + tid); i < (size_t)M * PLE / 8; i += (size_t)G * 512) {
            const f32x4 a = *((const f32x4*)p + 2 * i), b = *((const f32x4*)p + 2 * i + 1);
            u32x4 w; w.x = pkh(a[0], a[1]); w.y = pkh(a[2], a[3]); w.z = pkh(b[0], b[1]); w.w = pkh(b[2], b[3]);
            *((u32x4*)P16 + i) = w;
        }
        for (int i = vcu * 512 + tid; i < M * 8; i += G * 512) {
            const int m = i >> 3, f = i & 7;
            const float invf = (f == 0) ? 1.0f : (f == 1) ? 0.1939227432012558f : (f == 2) ? 0.03760603070259094f : (f == 3) ? 0.007292664609849453f : (f == 4) ? 0.0014142135623842478f
                             : (f == 5) ? 0.00027424818836152554f : (f == 6) ? 5.318296098266728e-05f : 1.0313386155758053e-05f;
            const float ang = (float)positions[m] * invf;
            float sn, cs; sincos_d((double)ang, sn, cs);
            ropec[i] = cs; ropes[i] = sn;
        }
    }
    SEAM(0);

    if (IN(1)) {
        { pg8::Gemm g{XN, Win_t, M, INW, D}; pg8::StaticOrder S; S.init(M, INW, G, bx);
          pg8::EpiIn E{Ub, MIX, Kb, Vb, ropec, ropes, kms};
          pg8::gemm_phase<pg8::EpiIn, pg8::StaticOrder, true, true>(lds + RING_OFF, g, S, E); }
        { pg8::Gemm g{P16, Wpp_t, M, D, PLE};
          pg8::StaticOrder S; if (G == 256) S.init(M, D, 128, bx & 127); else S.init(M, D, G, bx);
          pg8::EpiF16 E{PP, D};
          if (G != 256 || bx >= 128) pg8::gemm_phase<pg8::EpiF16, pg8::StaticOrder, true, true>(lds + RING_OFF, g, S, E); }
    }
    SEAM(1);

    if (IN(2)) {
#ifndef NO_ATTN
        const int nattn = BATCH * NHEAD * 4;
        for (int v = vcu; v < nattn; v += G) {
            const int bh = v >> 2, s = v & 3;
            for (int i = 0; i < 2; ++i) {
                const int qb = i == 0 ? 7 - s : s;
                unsigned sel = 0xFFFFFFFFu;
                if (qb > 3) sel = attn_body::moba_select(bh / NHEAD, bh % NHEAD, qb, MIX + AW, kms);
                asm volatile("" : "+v"(sel) :: "memory"); __builtin_amdgcn_sched_barrier(0);
                attn_body::attn_unit<8>(bh / NHEAD, bh % NHEAD, qb, MIX + AW, Kb, Vb, MIX + AW, sel, (char*)lds_raw);
            }
        }
#endif
#ifndef NO_CONV
        {
            LAS f16_t* ut = (LAS f16_t*)(lds + RING_OFF);
            LAS f16_t* wt = (LAS f16_t*)(lds + RING_OFF + 95 * 1024);
            __syncthreads();
            for (int i = tid; i < 32 * CONV_CH; i += 512) wt[i] = (i < CONVK * CONV_CH) ? (f16_t)conv_w[i] : (f16_t)0.f;
            ut[94 * CONV_CH + tid] = (f16_t)0.f;
            const int lane = tid & 63; const int c0 = lane * 8;
            for (int cu = vcu; cu < M / 64; cu += G) {
                const int t0 = cu * 64; const int tb = t0 & (SEQ - 1);
                __syncthreads();
                for (int i = tid; i < 94 * 64; i += 512) {
                    const int rr = i >> 6, ch = i & 63; const int tok = t0 - 30 + rr;
                    u32x4 v = {0u, 0u, 0u, 0u};
                    if (tb - 30 + rr >= 0) v = *(const u32x4*)(Ub + (size_t)tok * CONV_CH + ch * 8);
                    *(LAS u32x4*)(ut + rr * CONV_CH + ch * 8) = v;
                }
                __syncthreads();
                float acc[8][8];
#pragma unroll
                for (int i = 0; i < 8; ++i)
#pragma unroll
                    for (int e = 0; e < 8; ++e) acc[i][e] = 0.f;
                const LAS f16_t* ub = ut + (wave * 8) * CONV_CH + c0;
                const LAS f16_t* wb = wt + c0;
                f16x8 win[15];
#pragma unroll
                for (int i = 0; i < 7; ++i) win[8 + i] = *(const LAS f16x8*)(ub + i * CONV_CH);
#pragma unroll 1
                for (int jj = 0; jj < 32; jj += 8) {
#pragma unroll
                    for (int i = 0; i < 7; ++i) win[i] = win[8 + i];
#pragma unroll
                    for (int i = 0; i < 8; ++i) win[7 + i] = *(const LAS f16x8*)(ub + (jj + 7 + i) * CONV_CH);
#pragma unroll
                    for (int dj = 0; dj < 8; ++dj) {
                        const f16x8 wj = *(const LAS f16x8*)(wb + (jj + dj) * CONV_CH);
#pragma unroll
                        for (int i = 0; i < 8; ++i)
#pragma unroll
                            for (int e = 0; e < 8; ++e) acc[i][e] += (float)wj[e] * (float)win[dj + i][e];
                    }
                }
                float gam[8], bet[8], cb[8];
#pragma unroll
                for (int e = 0; e < 8; ++e) { gam[e] = conv_ln_g[c0 + e]; bet[e] = conv_ln_b[c0 + e]; cb[e] = conv_b[c0 + e]; }
#pragma unroll
                for (int i = 0; i < 8; ++i) {
                    float s = 0.f;
#pragma unroll
                    for (int e = 0; e < 8; ++e) { acc[i][e] += cb[e]; s += acc[i][e]; }
                    const float mu = wave_sum(s) * (1.0f / CONV_CH);
                    float q = 0.f;
#pragma unroll
                    for (int e = 0; e < 8; ++e) { const float d = acc[i][e] - mu; q += d * d; }
                    const float rstd = 1.0f / sqrtf(wave_sum(q) * (1.0f / CONV_CH) + EPS);
                    float y[8];
#pragma unroll
                    for (int e = 0; e < 8; ++e) { const float z = (acc[i][e] - mu) * rstd * gam[e] + bet[e]; y[e] = z * sigmoidf_(z); }
                    u32x4 w; w.x = pkh(y[0], y[1]); w.y = pkh(y[2], y[3]); w.z = pkh(y[4], y[5]); w.w = pkh(y[6], y[7]);
                    *(u32x4*)(MIX + (size_t)(t0 + wave * 8 + i) * D + c0) = w;
                }
            }
            __syncthreads();
        }
#endif
    }
    SEAM(2);

    if (IN(3)) {
        pg8::Gemm g{MIX, Wout_t, M, D, D}; pg8::StaticOrder S; S.init(M, D, G, bx);
        pg8::EpiRes E{x, out, XN, rss1};
        pg8::gemm_phase<pg8::EpiRes, pg8::StaticOrder, true, true>(lds + RING_OFF, g, S, E);
    }
    SEAM(3);

    if (IN(4)) {
        pg8::Gemm g{XN, Wup_t, M, 2 * DFF, D}; pg8::StaticOrder S; S.init(M, 2 * DFF, G, bx);
        pg8::EpiUp E{HID, rss1};
        pg8::gemm_phase<pg8::EpiUp, pg8::StaticOrder, true, true>(lds + RING_OFF, g, S, E);
    }
    SEAM(4);

    if (IN(5)) {
        pg8::Gemm g{HID, Wdn_t, M, D, DFF}; pg8::StaticOrder S; S.init(M, D, G, bx);
        pg8::EpiRes E{out, out, XN, rss2};
        pg8::gemm_phase<pg8::EpiRes, pg8::StaticOrder, true, true>(lds + RING_OFF, g, S, E);
    }
    SEAM(5);

    if (IN(6)) {
        pg8::Gemm g{XN, Wpg_t, M, D, D}; pg8::StaticOrder S; S.init(M, D, G, bx);
        pg8::EpiGate E{out, PP, rss2, rss3};
        pg8::gemm_phase<pg8::EpiGate, pg8::StaticOrder, true, true>(lds + RING_OFF, g, S, E);
    }
    SEAM(6);

    if (IN(7)) {
        int t7_ = threadIdx.x; asm volatile("" : "+v"(t7_)); const int lane = t7_ & 63;
        f32x4 gv[4];
#pragma unroll
        for (int j = 0; j < 4; ++j) gv[j] = *((const f32x4*)final_norm_g + lane + 64 * j);
        for (int m = gw; m < M; m += NGW) {
            const float rs = 1.0f / sqrtf(rss3[m] * (1.0f / D) + EPS);
            f32x4* xr = (f32x4*)(out + (size_t)m * D) + lane;
#pragma unroll
            for (int j = 0; j < 4; ++j) { f32x4 v = xr[64 * j]; v = v * rs * gv[j]; xr[64 * j] = v; }
        }
    }
#undef IN
#undef SEAM
}

extern "C" void kernel_launch(void* const* d_in, const int* in_sizes, int n_in, void* d_out, int out_size, void* d_ws, size_t ws_size, hipStream_t stream) {
    static int grid = 0;
    if (grid == 0) {
        if (n_in != 17 || out_size != M * D || ws_size < WS_END) { fprintf(stderr, "kernel_launch: unexpected shapes (n_in %d, out %d, ws %zu)\n", n_in, out_size, ws_size); grid = -1; return; }
        int dev = 0, cus = 0, per_cu = 0;
        if (hipGetDevice(&dev) != hipSuccess || hipDeviceGetAttribute(&cus, hipDeviceAttributeMultiprocessorCount, dev) != hipSuccess) { grid = -1; return; }
        if (hipFuncSetAttribute((const void*)fwd_kernel, hipFuncAttributeMaxDynamicSharedMemorySize, LDS_BYTES) != hipSuccess) { fprintf(stderr, "kernel_launch: hipFuncSetAttribute failed\n"); grid = -1; return; }
        if (hipOccupancyMaxActiveBlocksPerMultiprocessor(&per_cu, (const void*)fwd_kernel, NWAVES * 64, LDS_BYTES) != hipSuccess || per_cu < 1) { fprintf(stderr, "kernel_launch: occupancy query says %d\n", per_cu); per_cu = 1; }
        (void)hipGetLastError();
        grid = cus;
    }
    if (grid < 0) return;
    (void)hipMemsetAsync((char*)d_ws + WS_CTL, 0, CTL_ZERO_BYTES, stream);
    Args a{};
    for (int i = 0; i < 17; ++i) a.in[i] = d_in[i];
    a.out = (float*)d_out; a.ws = (unsigned char*)d_ws;
#ifndef MK_ONE_LAUNCH
    for (int ph = 0; ph < 8; ++ph) {
        a.ph_lo = ph; a.ph_hi = ph + 1;
        hipLaunchKernelGGL(fwd_kernel, dim3(grid), dim3(NWAVES * 64), LDS_BYTES, stream, a);
    }
#else
    a.ph_lo = 0; a.ph_hi = 8;
    void* kargs[] = {&a};
    hipError_t e = hipLaunchCooperativeKernel((const void*)fwd_kernel, dim3(grid), dim3(NWAVES * 64), kargs, LDS_BYTES, stream);
    if (e != hipSuccess) fprintf(stderr, "cooperative launch failed: %s (grid %d)\n", hipGetErrorString(e), grid);
#endif
}
```

```cpp
#include <hip/hip_runtime.h>
#include <hip/hip_cooperative_groups.h>
#include <cstdio>
#include <cstdint>
#include <cmath>
namespace cg = cooperative_groups;
#ifndef MK_MULTI_LAUNCH
#define MK_ONE_LAUNCH 1
#endif

#define LAS __attribute__((address_space(3)))
#define GAS __attribute__((address_space(1)))
typedef _Float16 f16_t;
typedef _Float16 f16x8 __attribute__((ext_vector_type(8)));
typedef _Float16 f16x4 __attribute__((ext_vector_type(4)));
typedef _Float16 f16x2 __attribute__((ext_vector_type(2)));
typedef float f32x2 __attribute__((ext_vector_type(2)));
typedef float f32x4 __attribute__((ext_vector_type(4)));
typedef float f32x16 __attribute__((ext_vector_type(16)));
typedef unsigned u32x4 __attribute__((ext_vector_type(4)));
typedef unsigned u32x2 __attribute__((ext_vector_type(2)));

constexpr int BATCH = 8, SEQ = 2048, D = 1024, M = BATCH * SEQ;
constexpr int CONV_CH = 512, NHEAD = 8, HD = 64, AW = 512, INW = 2560, DFF = 2816, PLE = 256, CONVK = 31, MOBA = 256, NBLK = SEQ / MOBA;
constexpr float EPS = 1e-6f;
constexpr float LOG2E = 1.4426950408889634f;
constexpr float C2 = 0.125f * 1.4426950408889634f;

__device__ __forceinline__ unsigned pkh(float lo, float hi) { f32x2 v = {lo, hi}; f16x2 h = __builtin_convertvector(v, f16x2); return __builtin_bit_cast(unsigned, h); }
__device__ __forceinline__ float sigmoidf_(float x) { return __builtin_amdgcn_rcpf(1.0f + __builtin_amdgcn_exp2f(-x * LOG2E)); }

namespace pg8 {
constexpr int BM = 256, BK = 64, HALF = 128, HTB = HALF * BK * 2, STAGE_BYTES = 8 * HTB, NXCD = 8, WGM = 8;
__host__ __device__ __forceinline__ int lds_byte(int r, int c) { const int st = (r >> 4) * 2 + (c >> 5), rr = r & 15, cc = c & 31, ob = rr * 64 + cc * 2; return st * 1024 + (ob ^ (((ob >> 9) & 1) << 5)); }
__host__ __device__ __forceinline__ void stage_rc(int b, int& R, int& C) { const int st = b / 1024, sb = b % 1024, swz = sb ^ (((sb >> 9) & 1) << 5); R = (st >> 1) * 16 + swz / 64; C = (st & 1) * 32 + (swz % 64) / 2; }
__host__ __device__ __forceinline__ int perm32(int rho) { const int n = rho >> 4, i = rho & 15; return 8 * (i >> 2) + 4 * n + (i & 3); }

__device__ __forceinline__ void glds16s(unsigned voff, const void* sbase, unsigned lds_dst) { unsigned keep;
    asm volatile("s_mov_b32 %0, m0\n\ts_mov_b32 m0, %3\n\ts_nop 0\n\tglobal_load_lds_dwordx4 %1, %2\n\ts_mov_b32 m0, %0" : "=&s"(keep) : "v"(voff), "s"(sbase), "s"(lds_dst) : "memory"); }
struct Unit { int pm, pn; };
struct Gemm { const f16_t* A; const f16_t* Bt; int M, N, K; };

struct StaticOrder {
    int nM, nN, nwg, G, c;
    __host__ __device__ void init(int M_, int N_, int G_, int c_) { nM = M_ / BM; nN = N_ / BM; nwg = nM * nN; G = G_; c = c_; }
    __host__ __device__ bool next(int i, Unit& u) const {
        const long L = (long)i * G + c; if (L >= nwg) return false;
        int wgid = (int)L; { const int q = nwg / NXCD, r = nwg % NXCD, xcd = wgid % NXCD, off = wgid / NXCD; wgid = (xcd < r ? xcd * (q + 1) : r * (q + 1) + (xcd - r) * q) + off; }
        const int nig = WGM * nN, gid = wgid / nig, fm = gid * WGM, gsz = (nM - fm) < WGM ? (nM - fm) : WGM;
        u.pm = fm + ((wgid % nig) % gsz); u.pn = (wgid % nig) / gsz; return true;
    }
    __device__ __forceinline__ void a_ready(const Unit&) const {}
    __device__ __forceinline__ void done(const Unit&) const {}
};
struct ListOrder {
    int first, count, nN;
    __device__ __forceinline__ bool next(int i, Unit& u) const { if (i >= count) return false; const int L = first + i; u.pm = L / nN; u.pn = L % nN; return true; }
    __device__ __forceinline__ void a_ready(const Unit&) const {}
    __device__ __forceinline__ void done(const Unit&) const {}
};


struct EpiIn {
    static constexpr bool PERM = true, AFTER_DRAIN = false;
    f16_t* U; f16_t* MIX; f16_t* Kb; f16_t* Vb; const float* ropec; const float* ropes; float* kms;
    __device__ __forceinline__ void operator()(const f32x4 (&acc)[2][2][4][2], const Unit& u, int wr, int wc, int fr_, int fq_) const {
        int t_ = threadIdx.x; asm volatile("" : "+v"(t_)); const int fr = t_ & 15, fq = (t_ >> 4) & 3;
        const int row0 = u.pm * BM + wr * 64 + fr;
        const int cw = wc * 32 + 8 * fq;
        if (u.pn < 4) {
#pragma unroll
            for (int ai = 0; ai < 2; ++ai)
#pragma unroll
                for (int m = 0; m < 4; ++m) {
                    const int row = row0 + ai * HALF + m * 16;
                    const f32x4 a0 = acc[ai][0][m][0], a1 = acc[ai][0][m][1], g0 = acc[ai][1][m][0], g1 = acc[ai][1][m][1];
                    u32x4 w;
                    w.x = pkh(a0[0] * sigmoidf_(g0[0]), a0[1] * sigmoidf_(g0[1])); w.y = pkh(a0[2] * sigmoidf_(g0[2]), a0[3] * sigmoidf_(g0[3]));
                    w.z = pkh(a1[0] * sigmoidf_(g1[0]), a1[1] * sigmoidf_(g1[1])); w.w = pkh(a1[2] * sigmoidf_(g1[2]), a1[3] * sigmoidf_(g1[3]));
                    *(u32x4*)(U + (size_t)row * CONV_CH + 128 * u.pn + cw) = w;
                }
        } else if (u.pn < 8) {
            const bool isq = u.pn < 6;
            const int ct = (u.pn - (isq ? 4 : 6)) * 256;
            const bool ropew = (wc & 1) == 0;
            const float sgn = (fq == 0) ? -1.f : 1.f;
            const bool ropel = fq < 2;
            float cs[2][8];
#pragma unroll
            for (int bj = 0; bj < 2; ++bj)
#pragma unroll
                for (int e = 0; e < 8; ++e) cs[bj][e] = 0.f;
#pragma unroll
            for (int ai = 0; ai < 2; ++ai)
#pragma unroll
                for (int m = 0; m < 4; ++m) {
                    const int row = row0 + ai * HALF + m * 16;
                    f32x4 c0 = {1.f, 1.f, 1.f, 1.f}, c1 = c0, s0 = {0.f, 0.f, 0.f, 0.f}, s1 = s0;
                    if (ropew) { c0 = *(const f32x4*)(ropec + (size_t)row * 8); c1 = *(const f32x4*)(ropec + (size_t)row * 8 + 4); s0 = *(const f32x4*)(ropes + (size_t)row * 8); s1 = *(const f32x4*)(ropes + (size_t)row * 8 + 4); }
#pragma unroll
                    for (int bj = 0; bj < 2; ++bj) {
                        f32x4 v0 = acc[ai][bj][m][0], v1 = acc[ai][bj][m][1];
                        if (ropew) {
                            f32x4 p0, p1;
#pragma unroll
                            for (int e = 0; e < 4; ++e) { p0[e] = __shfl_xor(v0[e], 16); p1[e] = __shfl_xor(v1[e], 16); }
                            if (ropel) { v0 = v0 * c0 + (p0 * s0) * sgn; v1 = v1 * c1 + (p1 * s1) * sgn; }
                        }
                        if (isq) {
                            v0 = v0 * C2; v1 = v1 * C2;
                            u32x4 w; w.x = pkh(v0[0], v0[1]); w.y = pkh(v0[2], v0[3]); w.z = pkh(v1[0], v1[1]); w.w = pkh(v1[2], v1[3]);
                            *(u32x4*)(MIX + (size_t)row * D + AW + ct + bj * HALF + cw) = w;
                        } else {
#pragma unroll
                            for (int e = 0; e < 4; ++e) { cs[bj][e] += v0[e]; cs[bj][4 + e] += v1[e]; }
                            u32x4 w; w.x = pkh(v0[0], v0[1]); w.y = pkh(v0[2], v0[3]); w.z = pkh(v1[0], v1[1]); w.w = pkh(v1[2], v1[3]);
                            *(u32x4*)(Kb + (size_t)row * AW + ct + bj * HALF + cw) = w;
                        }
                    }
                    asm volatile("" ::: "memory");
                }
            if (!isq) {
#pragma unroll
                for (int bj = 0; bj < 2; ++bj)
#pragma unroll
                    for (int e = 0; e < 8; ++e) { float s = cs[bj][e]; s += __shfl_xor(s, 1); s += __shfl_xor(s, 2); s += __shfl_xor(s, 4); s += __shfl_xor(s, 8); cs[bj][e] = s; }
                if (fr == 0) {
#pragma unroll
                    for (int bj = 0; bj < 2; ++bj)
#pragma unroll
                        for (int e = 0; e < 8; ++e) atomicAdd(kms + (size_t)u.pm * AW + ct + bj * HALF + cw + e, cs[bj][e]);
                }
            }
        } else {
            const int ct = (u.pn - 8) * 256;
#pragma unroll
            for (int ai = 0; ai < 2; ++ai)
#pragma unroll
                for (int m = 0; m < 4; ++m) {
                    const int row = row0 + ai * HALF + m * 16;
#pragma unroll
                    for (int bj = 0; bj < 2; ++bj) {
                        const f32x4 v0 = acc[ai][bj][m][0], v1 = acc[ai][bj][m][1];
                        u32x4 w; w.x = pkh(v0[0], v0[1]); w.y = pkh(v0[2], v0[3]); w.z = pkh(v1[0], v1[1]); w.w = pkh(v1[2], v1[3]);
                        *(u32x4*)(Vb + (size_t)row * AW + ct + bj * HALF + cw) = w;
                    }
                }
        }
    }
};
struct EpiF16 {
    static constexpr bool PERM = true, AFTER_DRAIN = false;
    f16_t* O; int ldc;
    __device__ __forceinline__ void operator()(const f32x4 (&acc)[2][2][4][2], const Unit& u, int wr, int wc, int fr_, int fq_) const {
        int t_ = threadIdx.x; asm volatile("" : "+v"(t_)); const int fr = t_ & 15, fq = (t_ >> 4) & 3;
        const int row0 = u.pm * BM + wr * 64 + fr; const int col0 = u.pn * BM + wc * 32 + 8 * fq;
#pragma unroll
        for (int ai = 0; ai < 2; ++ai)
#pragma unroll
            for (int m = 0; m < 4; ++m) { f16_t* rowp = O + (size_t)(row0 + ai * HALF + m * 16) * ldc + col0;
#pragma unroll
                for (int bj = 0; bj < 2; ++bj) { const f32x4 v0 = acc[ai][bj][m][0], v1 = acc[ai][bj][m][1];
                    u32x4 w; w.x = pkh(v0[0], v0[1]); w.y = pkh(v0[2], v0[3]); w.z = pkh(v1[0], v1[1]); w.w = pkh(v1[2], v1[3]);
                    *(u32x4*)(rowp + bj * HALF) = w; } }
    }
};
struct EpiRes {
    static constexpr bool PERM = false, AFTER_DRAIN = false;
    const float* base; float* out; f16_t* An; float* rowss;
    __device__ __forceinline__ void operator()(const f32x4 (&acc)[2][2][4][2], const Unit& u, int wr, int wc, int fr_, int fq_) const {
        int t_ = threadIdx.x; asm volatile("" : "+v"(t_)); const int fr = t_ & 15, fq = (t_ >> 4) & 3;
        const int col0 = u.pn * BM + wc * 32 + 4 * fq;
#pragma unroll
        for (int ai = 0; ai < 2; ++ai)
#pragma unroll
            for (int m = 0; m < 4; ++m) {
                const int r = u.pm * BM + ai * HALF + wr * 64 + m * 16 + fr; const size_t off = (size_t)r * D + col0;
                float ss = 0.f;
#pragma unroll
                for (int bj = 0; bj < 2; ++bj)
#pragma unroll
                    for (int n = 0; n < 2; ++n) {
                        const f32x4 bs = *(const f32x4*)(base + off + bj * HALF + n * 16);
                        const f32x4 o = bs + acc[ai][bj][m][n];
                        *(f32x4*)(out + off + bj * HALF + n * 16) = o;
                        ss += (o[0] * o[0] + o[1] * o[1]) + (o[2] * o[2] + o[3] * o[3]);
                        u32x2 w; w.x = pkh(o[0], o[1]); w.y = pkh(o[2], o[3]);
                        *(u32x2*)(An + off + bj * HALF + n * 16) = w;
                    }
                ss += __shfl_xor(ss, 16); ss += __shfl_xor(ss, 32);
                if (fq == 0) atomicAdd(rowss + r, ss);
            }
    }
};
struct EpiUp {
    static constexpr bool PERM = true, AFTER_DRAIN = false;
    f16_t* Hd; const float* rowss;
    __device__ __forceinline__ void operator()(const f32x4 (&acc)[2][2][4][2], const Unit& u, int wr, int wc, int fr_, int fq_) const {
        int t_ = threadIdx.x; asm volatile("" : "+v"(t_)); const int fr = t_ & 15, fq = (t_ >> 4) & 3;
        const int row0 = u.pm * BM + wr * 64 + fr; const int col0 = u.pn * HALF + wc * 32 + 8 * fq;
#pragma unroll
        for (int ai = 0; ai < 2; ++ai)
#pragma unroll
            for (int m = 0; m < 4; ++m) {
                const int row = row0 + ai * HALF + m * 16;
                const float rs = 1.0f / sqrtf(rowss[row] * (1.0f / D) + EPS);
                float h[8];
#pragma unroll
                for (int n = 0; n < 2; ++n)
#pragma unroll
                    for (int e = 0; e < 4; ++e) { const float g = acc[ai][0][m][n][e] * rs, up = acc[ai][1][m][n][e] * rs; h[4 * n + e] = g * sigmoidf_(g) * up; }
                u32x4 w; w.x = pkh(h[0], h[1]); w.y = pkh(h[2], h[3]); w.z = pkh(h[4], h[5]); w.w = pkh(h[6], h[7]);
                *(u32x4*)(Hd + (size_t)row * DFF + col0) = w;
            }
    }
};
struct EpiGate {
    static constexpr bool PERM = false, AFTER_DRAIN = false;
    const float* base; float* out; const f16_t* PP; const float* rowss_in; float* rowss_out;
    __device__ __forceinline__ void operator()(const f32x4 (&acc)[2][2][4][2], const Unit& u, int wr, int wc, int fr_, int fq_) const {
        int t_ = threadIdx.x; asm volatile("" : "+v"(t_)); const int fr = t_ & 15, fq = (t_ >> 4) & 3;
        const int col0 = u.pn * BM + wc * 32 + 4 * fq;
#pragma unroll
        for (int ai = 0; ai < 2; ++ai)
#pragma unroll
            for (int m = 0; m < 4; ++m) {
                const int r = u.pm * BM + ai * HALF + wr * 64 + m * 16 + fr; const size_t off = (size_t)r * D + col0;
                const float rs = 1.0f / sqrtf(rowss_in[r] * (1.0f / D) + EPS);
                float ss = 0.f;
#pragma unroll
                for (int bj = 0; bj < 2; ++bj)
#pragma unroll
                    for (int n = 0; n < 2; ++n) {
                        const f32x4 bs = *(const f32x4*)(base + off + bj * HALF + n * 16);
                        const f16x4 pp = *(const f16x4*)(PP + off + bj * HALF + n * 16);
                        const f32x4 a = acc[ai][bj][m][n] * rs;
                        f32x4 o;
#pragma unroll
                        for (int e = 0; e < 4; ++e) o[e] = bs[e] + sigmoidf_(a[e]) * (float)pp[e];
                        *(f32x4*)(out + off + bj * HALF + n * 16) = o;
                        ss += (o[0] * o[0] + o[1] * o[1]) + (o[2] * o[2] + o[3] * o[3]);
                    }
                ss += __shfl_xor(ss, 16); ss += __shfl_xor(ss, 32);
                if (fq == 0) atomicAdd(rowss_out + r, ss);
            }
    }
};

template <class Epi, class Sched, bool ALIGN_EPI = false, bool SP2 = false>
__device__ __forceinline__ void gemm_phase(LAS unsigned char* lds, const Gemm g, const Sched& S, const Epi& E) {
    const int tid = threadIdx.x, wid = __builtin_amdgcn_readfirstlane(tid >> 6), lane = tid & 63, wr = wid >> 2, wc = wid & 3, fr = lane & 15, fq = lane >> 4;
    const int K = g.K, nt = K / BK;
    unsigned voffA[2], voffB[2];
#pragma unroll
    for (int i = 0; i < 2; ++i) { int R, C; stage_rc(tid * 16 + i * 8192, R, C); const int Rb = Epi::PERM ? ((R & ~31) + perm32(R & 31)) : R;
        voffA[i] = (unsigned)(R * K + C) * 2u; voffB[i] = (unsigned)(Rb * K + C) * 2u; }
    const size_t kstep = (size_t)(BK * 2);
    const size_t hstep = (size_t)HALF * K * 2;
    const size_t tstep = 2 * hstep;
    const unsigned ldsw = (unsigned)wid * 1024u;
    const unsigned ldsb = (unsigned)(uintptr_t)lds;
    const int aoff = lds_byte(wr * 64 + fr, fq * 8), boff = lds_byte(wc * 32 + fr, fq * 8);
#define PG8_SA(b, h) (((b) * 2 + (h)) * HTB)
#define PG8_SB(b, h) ((4 + (b) * 2 + (h)) * HTB)
#define PG8_STAGE(bufoff, gbase, voff) do { _Pragma("unroll") for (int _i = 0; _i < 2; ++_i) \
        glds16s((voff)[_i], (const void*)(gbase), (unsigned)__builtin_amdgcn_readfirstlane(ldsb + (unsigned)(bufoff) + ldsw + _i * 8192u)); } while (0)
#define PG8_LDA(dst, b, h) do { _Pragma("unroll") for (int m = 0; m < 4; ++m) _Pragma("unroll") for (int k = 0; k < 2; ++k) dst[m][k] = *(const LAS f16x8*)(lds + PG8_SA(b, h) + aoff + m * 2048 + k * 1024); } while (0)
#define PG8_LDB(dst, b, h) do { _Pragma("unroll") for (int n = 0; n < 2; ++n) _Pragma("unroll") for (int k = 0; k < 2; ++k) dst[n][k] = *(const LAS f16x8*)(lds + PG8_SB(b, h) + boff + n * 2048 + k * 1024); } while (0)
#define PG8_MMA(ai, bj, At, Bt) do { __builtin_amdgcn_s_setprio(1); _Pragma("unroll") for (int m = 0; m < 4; ++m) _Pragma("unroll") for (int n = 0; n < 2; ++n) _Pragma("unroll") for (int k = 0; k < 2; ++k) \
        acc[ai][bj][m][n] = __builtin_amdgcn_mfma_f32_16x16x32_f16(Bt[n][k], At[m][k], acc[ai][bj][m][n], 0, 0, 0); __builtin_amdgcn_s_setprio(0); } while (0)
#define PG8_WAIT_V(n) asm volatile("s_waitcnt vmcnt(" #n ")" ::: "memory")
#define PG8_WAIT_L(n) asm volatile("s_waitcnt lgkmcnt(" #n ")" ::: "memory")
#define PG8_BAR __builtin_amdgcn_s_barrier()
#define PG8_SCHED __builtin_amdgcn_sched_barrier(0)
    Unit cur, nxt; int ui = 0;
    if (!S.next(0, cur)) return;
    f32x4 acc[2][2][4][2];
#pragma unroll
    for (int a = 0; a < 2; ++a)
#pragma unroll
        for (int b = 0; b < 2; ++b)
#pragma unroll
            for (int m = 0; m < 4; ++m)
#pragma unroll
                for (int n = 0; n < 2; ++n) acc[a][b][m][n] = (f32x4){0.f, 0.f, 0.f, 0.f};
    f16x8 At[4][2], B0[2][2], B1[2][2];
    const char* cA = (const char*)g.A + (size_t)cur.pm * tstep; const char* cB = (const char*)g.Bt + (size_t)cur.pn * tstep;
    S.a_ready(cur);
    if constexpr (SP2) {
        PG8_STAGE(PG8_SB(0, 0), cB, voffB); PG8_STAGE(PG8_SB(0, 1), cB + hstep, voffB); PG8_STAGE(PG8_SA(0, 0), cA, voffA); PG8_STAGE(PG8_SA(0, 1), cA + hstep, voffA);
        if (wr == 1) PG8_BAR;
        PG8_WAIT_V(2); PG8_BAR;
        PG8_STAGE(PG8_SB(1, 0), cB + kstep, voffB); PG8_STAGE(PG8_SA(1, 0), cA + kstep, voffA); PG8_STAGE(PG8_SB(1, 1), cB + hstep + kstep, voffB);
        PG8_WAIT_V(6); PG8_BAR;
    } else {
        PG8_STAGE(PG8_SB(0, 0), cB, voffB); PG8_STAGE(PG8_SA(0, 0), cA, voffA); PG8_STAGE(PG8_SB(0, 1), cB + hstep, voffB); PG8_STAGE(PG8_SA(0, 1), cA + hstep, voffA);
        if (wr == 1) PG8_BAR;
        PG8_WAIT_V(4); PG8_BAR;
        PG8_STAGE(PG8_SB(1, 0), cB + kstep, voffB); PG8_STAGE(PG8_SA(1, 0), cA + kstep, voffA); PG8_STAGE(PG8_SB(1, 1), cB + hstep + kstep, voffB);
        PG8_WAIT_V(6); PG8_BAR;
    }
    for (;;) {
        const bool has_next = S.next(ui + 1, nxt);
        const char* nA = has_next ? (const char*)g.A + (size_t)nxt.pm * tstep : cA; const char* nB = has_next ? (const char*)g.Bt + (size_t)nxt.pn * tstep : cB;
        for (int t = 0; t < nt; t += 2) {
            const bool last = (t == nt - 2);
            const char* a1 = cA + (size_t)(t + 1) * kstep;
            const char* a2 = last ? nA : cA + (size_t)(t + 2) * kstep; const char* b2 = last ? nB : cB + (size_t)(t + 2) * kstep;
            const char* a3 = a2 + kstep; const char* b3 = b2 + kstep;
            if (last && has_next) S.a_ready(nxt);
            if constexpr (SP2) {
            PG8_LDB(B0, 0, 0); PG8_LDB(B1, 0, 1); PG8_SCHED; PG8_LDA(At, 0, 0); PG8_STAGE(PG8_SA(1, 1), a1 + hstep, voffA);
            PG8_WAIT_V(8); PG8_WAIT_L(0); PG8_BAR; PG8_MMA(0, 0, At, B0); PG8_MMA(0, 1, At, B1); PG8_BAR; PG8_SCHED;
            PG8_LDA(At, 0, 1); PG8_STAGE(PG8_SB(0, 0), b2, voffB); PG8_STAGE(PG8_SB(0, 1), b2 + hstep, voffB); PG8_STAGE(PG8_SA(0, 0), a2, voffA);
            PG8_WAIT_V(8); PG8_WAIT_L(0); PG8_BAR; PG8_MMA(1, 0, At, B0); PG8_MMA(1, 1, At, B1); PG8_BAR; PG8_SCHED;
            PG8_LDB(B0, 1, 0); PG8_LDB(B1, 1, 1); PG8_SCHED; PG8_LDA(At, 1, 0); PG8_STAGE(PG8_SA(0, 1), a2 + hstep, voffA);
            PG8_WAIT_V(8); PG8_WAIT_L(0); PG8_BAR; PG8_MMA(0, 0, At, B0); PG8_MMA(0, 1, At, B1); PG8_BAR; PG8_SCHED;
            PG8_LDA(At, 1, 1); PG8_STAGE(PG8_SB(1, 0), b3, voffB); PG8_STAGE(PG8_SB(1, 1), b3 + hstep, voffB); PG8_STAGE(PG8_SA(1, 0), a3, voffA);
            PG8_WAIT_V(8); PG8_WAIT_L(0); PG8_BAR; PG8_MMA(1, 0, At, B0); PG8_MMA(1, 1, At, B1); PG8_BAR; PG8_SCHED;
            } else {
            PG8_LDB(B0, 0, 0); PG8_SCHED; PG8_LDA(At, 0, 0); PG8_STAGE(PG8_SA(1, 1), a1 + hstep, voffA);
            PG8_WAIT_L(8); PG8_BAR; PG8_WAIT_L(0); PG8_MMA(0, 0, At, B0); PG8_BAR; PG8_SCHED;
            PG8_LDB(B1, 0, 1); PG8_STAGE(PG8_SB(0, 0), b2, voffB);
            PG8_BAR; PG8_WAIT_L(0); PG8_MMA(0, 1, At, B1); PG8_BAR;
            PG8_LDA(At, 0, 1); PG8_STAGE(PG8_SA(0, 0), a2, voffA);
            PG8_BAR; PG8_WAIT_L(0); PG8_MMA(1, 0, At, B0); PG8_BAR; PG8_SCHED;
            PG8_STAGE(PG8_SB(0, 1), b2 + hstep, voffB);
            PG8_WAIT_V(6); PG8_BAR; PG8_MMA(1, 1, At, B1); PG8_BAR;
            PG8_LDB(B0, 1, 0); PG8_SCHED; PG8_LDA(At, 1, 0); PG8_STAGE(PG8_SA(0, 1), a2 + hstep, voffA);
            PG8_WAIT_L(8); PG8_BAR; PG8_WAIT_L(0); PG8_MMA(0, 0, At, B0); PG8_BAR; PG8_SCHED;
            PG8_LDB(B1, 1, 1); PG8_STAGE(PG8_SB(1, 0), b3, voffB);
            PG8_BAR; PG8_WAIT_L(0); PG8_MMA(0, 1, At, B1); PG8_BAR;
            PG8_LDA(At, 1, 1); PG8_STAGE(PG8_SA(1, 0), a3, voffA);
            PG8_BAR; PG8_WAIT_L(0); PG8_MMA(1, 0, At, B0); PG8_BAR; PG8_SCHED;
            PG8_STAGE(PG8_SB(1, 1), b3 + hstep, voffB);
            PG8_WAIT_V(6); PG8_BAR; PG8_MMA(1, 1, At, B1); PG8_BAR;
            }
        }
        if constexpr (ALIGN_EPI) { if (wr == 0) PG8_BAR; }
        if constexpr (!Epi::AFTER_DRAIN) { E(acc, cur, wr, wc, fr, fq); S.done(cur); }
        if (!has_next) break;
#pragma unroll
        for (int a = 0; a < 2; ++a)
#pragma unroll
            for (int b = 0; b < 2; ++b)
#pragma unroll
                for (int m = 0; m < 4; ++m)
#pragma unroll
                    for (int n = 0; n < 2; ++n) acc[a][b][m][n] = (f32x4){0.f, 0.f, 0.f, 0.f};
        cur = nxt; cA = nA; cB = nB; ++ui;
        if constexpr (ALIGN_EPI) { if (wr == 1) PG8_BAR; }
    }
    PG8_WAIT_V(0);
    if constexpr (!ALIGN_EPI) { if (wr == 0) PG8_BAR; }
    PG8_BAR;
#undef PG8_SA
#undef PG8_SB
#undef PG8_STAGE
#undef PG8_LDA
#undef PG8_LDB
#undef PG8_MMA
#undef PG8_WAIT_V
#undef PG8_WAIT_L
#undef PG8_BAR
#undef PG8_SCHED
}
}

namespace attn_body {
constexpr int NW = 8, QBLK = 32, QB = QBLK * NW, KVBLK = 64;
constexpr int QP = D;
constexpr int KP = AW;
__device__ __forceinline__ int crow(int r, int hi) { return (r & 3) + 8 * (r >> 2) + 4 * hi; }
#define SBAR() __builtin_amdgcn_sched_barrier(0)
__device__ __forceinline__ void cmask(f32x16& p0, f32x16& p1, int jb, int qrel, int hi) {
    const float NEG = -INFINITY; int kb = 64 * jb + 4 * hi;
#pragma unroll
    for (int r = 0; r < 16; ++r) { int kv = kb + (r & 3) + 8 * (r >> 2); if (kv > qrel) p0[r] = NEG; if (kv + 32 > qrel) p1[r] = NEG; }
}
__device__ __forceinline__ void mmask(f32x16& p0, f32x16& p1, bool keep) {
    const float NEG = -INFINITY;
#pragma unroll
    for (int r = 0; r < 16; ++r) { p0[r] = keep ? p0[r] : NEG; p1[r] = keep ? p1[r] : NEG; }
}
constexpr int NSLOT = 3, SLOTB = 8192;
constexpr int LDS_K = 0, LDS_V = NSLOT * SLOTB, LDS_WS = 2 * NSLOT * SLOTB, LDS_OST = LDS_WS + NW * 64 * 4, LDS_BYTES = LDS_OST + NW * 4096;
__device__ __forceinline__ void glds16(const void* gsrc, unsigned lds_dst) { unsigned keep;
    asm volatile("s_mov_b32 %0, m0\n\ts_mov_b32 m0, %2\n\ts_nop 0\n\tglobal_load_lds_dwordx4 %1, off\n\ts_mov_b32 m0, %0" : "=&s"(keep) : "v"(gsrc), "s"(lds_dst) : "memory"); }
__device__ __forceinline__ float max3f(float a, float b, float c) { float r; asm("v_max3_f32 %0, %1, %2, %3" : "=v"(r) : "v"(a), "v"(b), "v"(c)); return r; }
__device__ __forceinline__ float max2f(float a, float b) { float r; asm("v_max_f32_e32 %0, %1, %2" : "=v"(r) : "v"(a), "v"(b)); return r; }
__device__ __forceinline__ float fadd_s(float a, float b) { float r; asm("v_add_f32_e32 %0, %1, %2" : "=v"(r) : "v"(a), "v"(b)); return r; }
__device__ __forceinline__ float fsub_s(float a, float b) { float r; asm("v_sub_f32_e32 %0, %1, %2" : "=v"(r) : "v"(a), "v"(b)); return r; }
#define WAIT_BAR(N) asm volatile("s_waitcnt vmcnt(" #N ") lgkmcnt(0)\n\ts_barrier" ::: "memory")

__device__ __forceinline__ void qkt(f32x16& p0, f32x16& p1, const char* Kslot, const f16x8* qr, const f32x16& negm, int r32, int hi) {
    const char* kb = Kslot + hi * 1024 + r32 * 16;
#pragma unroll
    for (int d0 = 0; d0 < 4; ++d0) {
        const f16x8 b0 = *reinterpret_cast<const f16x8*>(kb + d0 * 2048);
        const f16x8 b1 = *reinterpret_cast<const f16x8*>(kb + d0 * 2048 + 512);
        if (d0 == 0) { p0 = __builtin_amdgcn_mfma_f32_32x32x16_f16(b0, qr[0], negm, 0, 0, 0); p1 = __builtin_amdgcn_mfma_f32_32x32x16_f16(b1, qr[0], negm, 0, 0, 0); }
        else { p0 = __builtin_amdgcn_mfma_f32_32x32x16_f16(b0, qr[d0], p0, 0, 0, 0); p1 = __builtin_amdgcn_mfma_f32_32x32x16_f16(b1, qr[d0], p1, 0, 0, 0); } }
}
typedef __attribute__((address_space(3))) const char* lds_cptr;
typedef short v4i16_t __attribute__((ext_vector_type(4)));
__device__ __forceinline__ void kload8(f16x8* kf, lds_cptr kp) {
    kf[0] = *(const LAS f16x8*)(kp);        kf[1] = *(const LAS f16x8*)(kp + 512);
    kf[2] = *(const LAS f16x8*)(kp + 2048); kf[3] = *(const LAS f16x8*)(kp + 2560);
    kf[4] = *(const LAS f16x8*)(kp + 4096); kf[5] = *(const LAS f16x8*)(kp + 4608);
    kf[6] = *(const LAS f16x8*)(kp + 6144); kf[7] = *(const LAS f16x8*)(kp + 6656);
}
__device__ __forceinline__ void kload2(f16x8* kf, lds_cptr kp, int j) { kf[2 * j] = *(const LAS f16x8*)(kp + j * 2048); kf[2 * j + 1] = *(const LAS f16x8*)(kp + j * 2048 + 512); }
__device__ __forceinline__ f16x4 vtr(lds_cptr p) { return __builtin_bit_cast(f16x4, __builtin_amdgcn_ds_read_tr16_b64_v4i16((LAS v4i16_t*)p)); }
__device__ __forceinline__ float rowmax(const f32x16& p0, const f32x16& p1) {
    float a = max3f(p0[0], p0[1], p1[0]), b = max3f(p0[2], p0[3], p1[1]); a = max3f(a, p1[2], p1[3]);
#pragma unroll
    for (int r = 4; r < 16; r += 4) { a = max3f(a, p0[r], p0[r + 1]); b = max3f(b, p0[r + 2], p0[r + 3]); a = max3f(a, p1[r], p1[r + 1]); b = max3f(b, p1[r + 2], p1[r + 3]); }
    const float m = max2f(a, b);
    auto rr = __builtin_amdgcn_permlane32_swap(__float_as_uint(m), __float_as_uint(m), false, false);
    return max2f(__uint_as_float(rr[0]), __uint_as_float(rr[1]));
}
__device__ __forceinline__ void pv(f32x16* o, int vb, f16x8 pa0, f16x8 pa1, f16x8 pa2, f16x8 pa3) {
#pragma unroll
    for (int d0 = 0; d0 < 2; ++d0) { f16x4 lo[4], hi[4];
#pragma unroll
        for (int ks = 0; ks < 4; ++ks) {
            asm volatile("ds_read_b64_tr_b16 %0,%1 offset:%c2" : "=&v"(lo[ks]) : "v"(vb), "i"(d0 * 4096 + ks * 1024) : "memory");
            asm volatile("ds_read_b64_tr_b16 %0,%1 offset:%c2" : "=&v"(hi[ks]) : "v"(vb), "i"(d0 * 4096 + ks * 1024 + 512) : "memory"); }
        asm volatile("s_waitcnt lgkmcnt(0)" ::: "memory"); SBAR();
#define PK(k) __builtin_shufflevector(lo[k], hi[k], 0, 1, 2, 3, 4, 5, 6, 7)
        o[d0] = __builtin_amdgcn_mfma_f32_32x32x16_f16(pa0, PK(0), o[d0], 0, 0, 0);
        o[d0] = __builtin_amdgcn_mfma_f32_32x32x16_f16(pa1, PK(1), o[d0], 0, 0, 0);
        o[d0] = __builtin_amdgcn_mfma_f32_32x32x16_f16(pa2, PK(2), o[d0], 0, 0, 0);
        o[d0] = __builtin_amdgcn_mfma_f32_32x32x16_f16(pa3, PK(3), o[d0], 0, 0, 0);
#undef PK
    }
}

__device__ __forceinline__ unsigned moba_select(int b, int h, int qb, const f16_t* Q, const float* __restrict__ kms) {
    int tid_ = threadIdx.x; asm volatile("" : "+v"(tid_));
    const int tid = tid_, lane = tid & 63, r32 = lane & 31, hi = lane >> 5; const int wid = __builtin_amdgcn_readfirstlane(tid >> 6);
    const f16_t* Qw = Q + ((long)b * SEQ + qb * QB + wid * QBLK) * QP + h * HD;
    f16x8 qr[4];
#pragma unroll
    for (int d0 = 0; d0 < 4; ++d0) qr[d0] = *reinterpret_cast<const f16x8*>(&Qw[(long)r32 * QP + d0 * 16 + hi * 8]);
    float gsc[7];
#pragma unroll
    for (int j = 0; j < 7; ++j) {
        float s = 0.f;
        if (j < qb) {
            const float* km = kms + (size_t)(b * NBLK + j) * AW + h * HD + hi * 8;
#pragma unroll
            for (int d0 = 0; d0 < 4; ++d0) {
                const f32x4 k0 = *(const f32x4*)(km + d0 * 16), k1 = *(const f32x4*)(km + d0 * 16 + 4);
                s += (float)qr[d0][0] * k0[0] + (float)qr[d0][1] * k0[1] + (float)qr[d0][2] * k0[2] + (float)qr[d0][3] * k0[3];
                s += (float)qr[d0][4] * k1[0] + (float)qr[d0][5] * k1[1] + (float)qr[d0][6] * k1[2] + (float)qr[d0][7] * k1[3];
            }
            s += __shfl_xor(s, 32);
            asm volatile("" ::: "memory");
        } else s = -INFINITY;
        gsc[j] = s;
    }
    unsigned sm = 0u;
#pragma unroll
    for (int j = 0; j < 7; ++j) {
        int cnt = 0;
#pragma unroll
        for (int i = 0; i < 7; ++i) { if (i == j) continue; const bool ahead = (gsc[i] > gsc[j]) || (gsc[i] == gsc[j] && i < j); cnt += ahead ? 1 : 0; }
        if (j < qb && cnt < 3) sm |= (1u << j);
    }
    return sm;
}

template <int THRL> __device__ __forceinline__ void attn_unit(int b, int h, int qb, const f16_t* Q, const f16_t* __restrict__ K, const f16_t* __restrict__ V, f16_t* O, const unsigned selmask, char* shm) {
    int tid_ = threadIdx.x; asm volatile("" : "+v"(tid_));
    const int tid = tid_, lane = tid & 63, r32 = lane & 31, hi = lane >> 5; const int wid = __builtin_amdgcn_readfirstlane(tid >> 6);
    const long rowbase = (long)b * SEQ; const int q0 = qb * QB;
    const f16_t* Qw = Q + (rowbase + q0 + wid * QBLK) * QP + h * HD;
    const f16_t* Kh = K + rowbase * KP + h * HD, *Vh = V + rowbase * KP + h * HD;
    const unsigned lds0 = (unsigned)(uintptr_t)shm;
    float* wsf = (float*)(shm + LDS_WS) + wid * 64;
    const f16_t* ksrc = Kh + (long)lane * KP + wid * 8;
    const f16_t* vsrc = Vh + (long)(16 * (wid & 3) + (lane >> 2)) * KP + (wid >> 2) * 32 + (lane & 3) * 8;
    const unsigned kdst = lds0 + LDS_K + wid * 1024, vdst = lds0 + LDS_V + wid * 1024;
#define DMA_K(t, slot) glds16(ksrc + (long)(t) * KVBLK * KP, (unsigned)__builtin_amdgcn_readfirstlane(kdst + (slot)))
#define DMA_V(t, slot) glds16(vsrc + (long)(t) * KVBLK * KP, (unsigned)__builtin_amdgcn_readfirstlane(vdst + (slot)))
    const int vb0 = (int)(lds0 + LDS_V) + ((lane >> 4) & 1) * 32 + (lane & 3) * 8 + (4 * hi + ((lane & 15) >> 2)) * 64;
    const char* Kbase = shm + LDS_K; f16x8 kf[8];
    const lds_cptr shm3 = (lds_cptr)shm; const lds_cptr kp0 = shm3 + LDS_K + hi * 1024 + r32 * 16; const lds_cptr vp0 = shm3 + LDS_V + ((lane >> 4) & 1) * 32 + (lane & 3) * 8 + (4 * hi + ((lane & 15) >> 2)) * 64;
    const int NT = (q0 + QB) / KVBLK;
    DMA_K(0, 0); DMA_V(0, 0); DMA_K(1, SLOTB);
    f16x8 qr[4];
#pragma unroll
    for (int d0 = 0; d0 < 4; ++d0) qr[d0] = *reinterpret_cast<const f16x8*>(&Qw[(long)r32 * QP + d0 * 16 + hi * 8]);
    const bool maskon = qb > 3;
    float mhat = 0.f, l_reg = 0.f; float z_; asm volatile("v_mov_b32 %0, 0" : "=v"(z_)); f32x16 o[2]; f32x16 negm;
    _Pragma("unroll") for (int r = 0; r < 16; ++r) { o[0][r] = z_; o[1][r] = z_; negm[r] = z_; } asm volatile("" : "+v"(negm));
#define CMASK(P0, P1, t) do { int jb_ = (t) - (NT - 4); if (jb_ >= 0) { int q_ = r32; asm volatile("" : "+v"(q_)); cmask(P0, P1, jb_, wid * QBLK + q_, hi); } else if (maskon) mmask(P0, P1, ((selmask >> ((t) >> 2)) & 1u) != 0u); } while (0)
    bool resc = false;
#define START(P0, P1) do { const float rm = rowmax(P0, P1); resc = false; \
    { const float dl = max2f(rm, -100.f); mhat = fadd_s(mhat, dl); \
      _Pragma("unroll") for (int r = 0; r < 16; ++r) { P0[r] = fsub_s(P0[r], dl); P1[r] = fsub_s(P1[r], dl); } \
      _Pragma("unroll") for (int r = 0; r < 16; ++r) negm[r] = -mhat; asm volatile("" : "+v"(negm)); } \
    _Pragma("unroll") for (int r = 0; r < 16; ++r) P0[r] = __builtin_amdgcn_exp2f(P0[r]); } while (0)
#define RESC() do { if (resc) { asm volatile("s_waitcnt lgkmcnt(0)" ::: "memory"); \
      _Pragma("unroll") for (int d_ = 0; d_ < 2; ++d_) _Pragma("unroll") for (int r = 0; r < 16; ++r) o[d_][r] *= wsf[crow(r, hi)]; } } while (0)
    f32x16 pA0, pA1, pB0, pB1;
    int sl_prev = 0, sl_cur = 0, sl_next = SLOTB;
#define ROT() do { sl_prev = sl_cur; sl_cur = sl_next; sl_next = (sl_next == (NSLOT - 1) * SLOTB) ? 0 : sl_next + SLOTB; } while (0)
    DMA_K(2, 2 * SLOTB);
    WAIT_BAR(3);
    qkt(pA0, pA1, Kbase, qr, negm, r32, hi); asm volatile("s_nop 15\n\ts_nop 7" : "+v"(pA0), "+v"(pA1)); CMASK(pA0, pA1, 0);
    START(pA0, pA1);
    _Pragma("unroll") for (int r = 0; r < 16; ++r) pA1[r] = __builtin_amdgcn_exp2f(pA1[r]);
    WAIT_BAR(0);
    DMA_K(3, 0); DMA_V(1, SLOTB);
    ROT();
    kload8(kf, kp0 + sl_cur);
    WAIT_BAR(2);
    f16x4 vlo[8], vhi[8]; u32x4 pw0, pw1, pw2, pw3;
#define PKW(P, B) pkh(P[B], P[B + 1])
#define PAF(k) __builtin_bit_cast(f16x8, pw##k)
#define VFR(i) __builtin_shufflevector(vlo[i], vhi[i], 0, 1, 2, 3, 4, 5, 6, 7)
#define PIN(x) asm volatile("" : "+v"(x))
#define MX3(a, b, c) __builtin_fmaxf(__builtin_fmaxf((a), (b)), (c))
#define GAPA(MF, A0, A1, A2, A3, W0, W1, PW) do { MF; sacc += A0; sacc += A1; sacc += A2; sacc += A3; PIN(sacc); W0; W1; PIN(PW); SBAR(); } while (0)
#define EX(v) __builtin_amdgcn_exp2f(v)
#define GAPB(MF, X, B) do { MF; X[B] = EX(X[B]); X[B + 1] = EX(X[B + 1]); X[B + 2] = EX(X[B + 2]); X[B + 3] = EX(X[B + 3]); PIN(X); SBAR(); } while (0)
#define VRD(i) do { vlo[i] = vtr(vp_ + (((i) >> 2) * 4096 + ((i) & 3) * 1024)); vhi[i] = vtr(vp_ + (((i) >> 2) * 4096 + ((i) & 3) * 1024 + 512)); } while (0)
#define KRD(G, j) do { if (G) { kload2(kf, kp0 + sl_next, j); SBAR(); } } while (0)
#define MF16(a, b, c) __builtin_amdgcn_mfma_f32_32x32x16_f16(a, b, c, 0, 0, 0)
#define STEP(C0, C1, P0, P1, t, GK, GV, GL) do { SBAR(); \
    const lds_cptr vp_ = vp0 + sl_prev; \
    VRD(0); SBAR(); float sacc = (P0[0] + P0[1]); \
    GAPA(C0 = MF16(kf[0], qr[0], negm), P0[2], P0[3], P0[4], P0[5],     pw0[0] = PKW(P0, 0), pw0[1] = PKW(P0, 2), pw0); \
    VRD(4); SBAR(); GAPA(C1 = MF16(kf[1], qr[0], negm), P0[6], P0[7], P0[8], P0[9],     pw0[2] = PKW(P0, 4), pw0[3] = PKW(P0, 6), pw0); \
    VRD(1); SBAR(); GAPA(C0 = MF16(kf[2], qr[1], C0),   P0[10], P0[11], P0[12], P0[13], pw1[0] = PKW(P0, 8), pw1[1] = PKW(P0, 10), pw1); \
    VRD(5); SBAR(); GAPA(C1 = MF16(kf[3], qr[1], C1),   P0[14], P0[15], P1[0], P1[1],   pw1[2] = PKW(P0, 12), pw1[3] = PKW(P0, 14), pw1); \
    VRD(2); SBAR(); GAPA(C0 = MF16(kf[4], qr[2], C0),   P1[2], P1[3], P1[4], P1[5],     pw2[0] = PKW(P1, 0), pw2[1] = PKW(P1, 2), pw2); \
    VRD(6); SBAR(); GAPA(C1 = MF16(kf[5], qr[2], C1),   P1[6], P1[7], P1[8], P1[9],     pw2[2] = PKW(P1, 4), pw2[3] = PKW(P1, 6), pw2); \
    VRD(3); SBAR(); GAPA(C0 = MF16(kf[6], qr[3], C0),   P1[10], P1[11], P1[12], P1[13], pw3[0] = PKW(P1, 8), pw3[1] = PKW(P1, 10), pw3); \
    VRD(7); SBAR(); GAPA(C1 = MF16(kf[7], qr[3], C1),   P1[14], P1[15], 0.f, 0.f,       pw3[2] = PKW(P1, 12), pw3[3] = PKW(P1, 14), pw3); \
    l_reg += sacc; \
    if (GK) { DMA_K((t) + 3, sl_cur); } if (GV) { DMA_V((t) + 1, sl_next); } \
    CMASK(C0, C1, t); \
    { float a = MX3(C0[0], C0[1], C1[0]), b_ = MX3(C0[2], C0[3], C1[1]); a = MX3(a, C1[2], C1[3]); \
      _Pragma("unroll") for (int r = 4; r < 16; r += 4) { a = MX3(a, C0[r], C0[r + 1]); b_ = MX3(b_, C0[r + 2], C0[r + 3]); a = MX3(a, C1[r], C1[r + 1]); b_ = MX3(b_, C1[r + 2], C1[r + 3]); } \
      float rm = __builtin_fmaxf(a, b_); { auto rr = __builtin_amdgcn_permlane32_swap(__float_as_uint(rm), __float_as_uint(rm), false, false); rm = __builtin_fmaxf(__uint_as_float(rr[0]), __uint_as_float(rr[1])); } \
      resc = false; \
      if (__builtin_expect(__any(rm > (float)THRL), 0)) { const float dl = __builtin_fmaxf(rm, 0.f); mhat += dl; \
        _Pragma("unroll") for (int r = 0; r < 16; ++r) { C0[r] -= dl; C1[r] -= dl; } \
        _Pragma("unroll") for (int r = 0; r < 16; ++r) negm[r] = -mhat; asm volatile("" : "+v"(negm)); \
        const float f = __builtin_amdgcn_exp2f(-dl); l_reg *= f; if (hi == 0) wsf[r32] = f; resc = true; } } \
    SBAR(); \
    GAPB(o[0] = MF16(PAF(0), VFR(0), o[0]), C0, 0); \
    GAPB(o[1] = MF16(PAF(0), VFR(4), o[1]), C0, 4); \
    KRD(GL, 0); GAPB(o[0] = MF16(PAF(1), VFR(1), o[0]), C0, 8); \
    KRD(GL, 1); GAPB(o[1] = MF16(PAF(1), VFR(5), o[1]), C0, 12); \
    KRD(GL, 2); GAPB(o[0] = MF16(PAF(2), VFR(2), o[0]), C1, 0); \
    KRD(GL, 3); GAPB(o[1] = MF16(PAF(2), VFR(6), o[1]), C1, 4); \
    GAPB(o[0] = MF16(PAF(3), VFR(3), o[0]), C1, 8); \
    GAPB(o[1] = MF16(PAF(3), VFR(7), o[1]), C1, 12); \
    } while (0)
    int t = 1;
    for (; t + 5 < NT; t += 2) {
        STEP(pB0, pB1, pA0, pA1, t, true, true, true);     WAIT_BAR(2); RESC(); ROT();
        STEP(pA0, pA1, pB0, pB1, t + 1, true, true, true); WAIT_BAR(2); RESC(); ROT();
    }
#define ENDW(tt) do { if ((tt) + 3 < NT) { WAIT_BAR(2); } else if ((tt) + 2 < NT) { WAIT_BAR(1); } else { WAIT_BAR(0); } } while (0)
    for (; t + 1 < NT; t += 2) {
        STEP(pB0, pB1, pA0, pA1, t, (t + 3 < NT), (t + 1 < NT), (t + 1 < NT));         ENDW(t);     RESC(); ROT();
        STEP(pA0, pA1, pB0, pB1, t + 1, (t + 4 < NT), (t + 2 < NT), (t + 2 < NT));     ENDW(t + 1); RESC(); ROT();
    }
    STEP(pB0, pB1, pA0, pA1, NT - 1, false, false, false); RESC();
    { float sacc = pB0[0] + pB0[1]; _Pragma("unroll") for (int r = 2; r < 16; ++r) sacc += pB0[r]; _Pragma("unroll") for (int r = 0; r < 16; ++r) sacc += pB1[r]; l_reg += sacc;
      pw0 = (u32x4){PKW(pB0, 0), PKW(pB0, 2), PKW(pB0, 4), PKW(pB0, 6)}; pw1 = (u32x4){PKW(pB0, 8), PKW(pB0, 10), PKW(pB0, 12), PKW(pB0, 14)}; pw2 = (u32x4){PKW(pB1, 0), PKW(pB1, 2), PKW(pB1, 4), PKW(pB1, 6)}; pw3 = (u32x4){PKW(pB1, 8), PKW(pB1, 10), PKW(pB1, 12), PKW(pB1, 14)};
      SBAR(); pv(o, vb0 + sl_cur, PAF(0), PAF(1), PAF(2), PAF(3)); }
#undef PKW
#undef PAF
#undef VFR
#undef PIN
#undef MX3
#undef GAPA
#undef GAPB
#undef EX
#undef VRD
#undef KRD
#undef STEP
#undef ENDW
#undef MF16
    { auto rr = __builtin_amdgcn_permlane32_swap(__float_as_uint(l_reg), __float_as_uint(l_reg), false, false); l_reg = __uint_as_float(rr[0]) + __uint_as_float(rr[1]); }
    if (hi == 0) wsf[32 + r32] = l_reg; asm volatile("s_waitcnt lgkmcnt(0)" ::: "memory");
    float rli[16];
#pragma unroll
    for (int r = 0; r < 16; ++r) rli[r] = __builtin_amdgcn_rcpf(wsf[32 + crow(r, hi)]);
    f16_t* Ow = O + (rowbase + q0 + wid * QBLK) * QP + h * HD;
    { f16_t* stg = (f16_t*)(shm + LDS_OST) + wid * 2048;
#pragma unroll
      for (int r = 0; r < 16; ++r) { const int orow = crow(r, hi);
#pragma unroll
        for (int d0 = 0; d0 < 2; ++d0) stg[orow * 64 + d0 * 32 + r32] = (f16_t)(o[d0][r] * rli[r]); }
      asm volatile("s_waitcnt lgkmcnt(0)" ::: "memory");
#pragma unroll
      for (int i = 0; i < 4; ++i) { const int row = i * 8 + (lane >> 3), ch = lane & 7; const u32x4 v = *(const u32x4*)(stg + row * 64 + ch * 8); *(u32x4*)(Ow + (long)row * QP + ch * 8) = v; } }
    asm volatile("s_waitcnt lgkmcnt(0)\n\ts_barrier" ::: "memory");
#undef DMA_K
#undef DMA_V
#undef CMASK
#undef START
#undef RESC
#undef ROT
}
#undef SBAR
#undef WAIT_BAR
}

constexpr int NWAVES = 8;
constexpr size_t MiB = 1u << 20;
constexpr size_t WS_CTL = 0, CTL_ZERO_BYTES = 1 * MiB;
constexpr size_t WS_WIN = 1 * MiB, WS_WOUT = 6 * MiB, WS_WUP = 8 * MiB, WS_WDN = 19 * MiB, WS_WPG = 25 * MiB, WS_WPP = 27 * MiB;
constexpr size_t WS_ROPE = 28 * MiB;
constexpr size_t WS_XN = 29 * MiB;
constexpr size_t WS_PP = 61 * MiB;
constexpr size_t WS_HID = 93 * MiB;
constexpr size_t WS_P16 = 93 * MiB, WS_U = 101 * MiB, WS_K = 117 * MiB, WS_V = 133 * MiB, WS_MIX = 149 * MiB, WS_END = 181 * MiB;
constexpr size_t WS_DUMMY = 181 * MiB;
static_assert(WS_HID + (size_t)M * DFF * 2 <= WS_END && WS_MIX + (size_t)M * D * 2 <= WS_END, "ws map");
constexpr size_t CTL_BAR = 16384;
constexpr size_t CTL_KMS = 64 * 1024;
constexpr size_t CTL_RSS1 = 256 * 1024, CTL_RSS2 = 320 * 1024, CTL_RSS3 = 384 * 1024;
constexpr int RING_OFF = 0, RING_BYTES = 131072;
constexpr int LDSCTL_OFF = RING_BYTES, MISC_OFF = LDSCTL_OFF + 320;
constexpr int LDS_BYTES = 147456;
static_assert(attn_body::LDS_BYTES <= RING_BYTES, "attention LDS");


#define XB_TMO      128
#define XB_XCNT(j)  (256  + 64 * (j))
#define XB_XSUB(j)  (1280 + 64 * (j))
#define XB_XGEN(j)  (2304 + 64 * (j))
#define XB_TOP      3328
#define XB_TOPGEN   3392
#define XCD_BAR_WORDS 3456
#define XB_SPIN_CAP (1u << 18)
__device__ __forceinline__ unsigned xb_ld(unsigned* p)              { return __hip_atomic_load(p, __ATOMIC_RELAXED, __HIP_MEMORY_SCOPE_AGENT); }
__device__ __forceinline__ unsigned xb_add(unsigned* p, unsigned v) { return __hip_atomic_fetch_add(p, v, __ATOMIC_RELAXED, __HIP_MEMORY_SCOPE_AGENT); }
__device__ __forceinline__ unsigned xb_xcc_id() { return (unsigned)__builtin_amdgcn_s_getreg((3 << 11) | 20) & 0xFu; }
#define XB_SPIN(cond, bar) do { unsigned _sp = 0; while (cond) { __builtin_amdgcn_s_sleep(1); \
    if ((++_sp & 255u) == 0u) { if (xb_ld(&(bar)[XB_TMO])) break; if (_sp > XB_SPIN_CAP) { atomicAdd(&(bar)[XB_TMO], 1u); break; } } } } while (0)
struct XcdBarrier { unsigned* bar; unsigned x; volatile LAS unsigned* st; };
__device__ __forceinline__ XcdBarrier xcd_barrier_post(unsigned* bar, volatile LAS unsigned* st) {
    XcdBarrier b; b.bar = bar; b.x = xb_xcc_id(); b.st = st;
    if (threadIdx.x == 0) (void)xb_add(&bar[XB_XCNT(b.x)], 1u);
    return b;
}
__device__ __forceinline__ void xcd_barrier_complete(unsigned* bar, unsigned x, unsigned& nloc, unsigned& nx) {
    const unsigned G = gridDim.x * gridDim.y * gridDim.z;
    unsigned sum, cnt, mine, sp = 0u;
    for (;;) {
        sum = 0u; cnt = 0u; mine = 0u;
#pragma unroll
        for (unsigned j = 0; j < 16; ++j) { const unsigned c = xb_ld(&bar[XB_XCNT(j)]); sum += c; cnt += (c > 0u) ? 1u : 0u; mine = (j == x) ? c : mine; }
        if (sum == G) break;
        __builtin_amdgcn_s_sleep(1);
        if ((++sp & 255u) == 0u) { if (xb_ld(&bar[XB_TMO])) break; if (sp > XB_SPIN_CAP) { atomicAdd(&bar[XB_TMO], 1u); break; } }
    }
    nloc = mine > 0u ? mine : 1u; nx = cnt > 0u ? cnt : 1u;
}
__device__ __forceinline__ void xcd_barrier(const XcdBarrier& b) {
    asm volatile("s_waitcnt vmcnt(0)" ::: "memory");
    __syncthreads();
    if (threadIdx.x == 0) {
        unsigned* bar = b.bar;
        __builtin_amdgcn_s_waitcnt(0);
        unsigned nloc = b.st[0], nx = b.st[1];
        if (nloc == 0u) { xcd_barrier_complete(bar, b.x, nloc, nx); b.st[0] = nloc; b.st[1] = nx; }
        const unsigned old = xb_add(&bar[XB_XSUB(b.x)], 1u);
        const unsigned gen = old / nloc;
        if (old + 1u == (gen + 1u) * nloc) {
            __builtin_amdgcn_fence(__ATOMIC_RELEASE, "agent");
            asm volatile("s_waitcnt vmcnt(0)" ::: "memory");
            const unsigned og = xb_add(&bar[XB_TOP], 1u);
            const unsigned tg = og / nx;
            if (og + 1u == (tg + 1u) * nx) xb_add(&bar[XB_TOPGEN], 1u);
            else XB_SPIN(xb_ld(&bar[XB_TOPGEN]) == tg, bar);
            __builtin_amdgcn_fence(__ATOMIC_ACQUIRE, "agent");
            xb_add(&bar[XB_XGEN(b.x)], 1u);
            asm volatile("s_waitcnt vmcnt(0)" ::: "memory");
        } else {
            XB_SPIN(xb_ld(&bar[XB_XGEN(b.x)]) == gen, bar);
            __builtin_amdgcn_fence(__ATOMIC_ACQUIRE, "agent");
            asm volatile("s_waitcnt vmcnt(0)" ::: "memory");
        }
    }
    __syncthreads();
}

__device__ __forceinline__ float wave_sum(float v) {
#pragma unroll
    for (int o = 1; o < 64; o <<= 1) v += __shfl_xor(v, o);
    return v;
}

struct Args { const void* in[17]; float* out; unsigned char* ws; int ph_lo, ph_hi, dry, pad; };

__device__ __forceinline__ void p0_transpose_item(const float* W, int K, int N, f16_t* WT, const float* gain, LAS float* scr, int k0, int n0, int drow0, int lane) {
#pragma unroll 8
    for (int i = 0; i < 32; ++i) { const int kk = 2 * i + (lane >> 5); float v = W[(size_t)(k0 + kk) * N + n0 + (lane & 31)]; if (gain) v *= gain[k0 + kk]; scr[kk * 33 + (lane & 31)] = v; }
    asm volatile("s_waitcnt lgkmcnt(0)" ::: "memory");
    const int c = lane & 7;
#pragma unroll
    for (int j = 0; j < 4; ++j) { const int n = (lane >> 3) + 8 * j; const LAS float* s = scr + (8 * c) * 33 + n;
        u32x4 o; o.x = pkh(s[0 * 33], s[1 * 33]); o.y = pkh(s[2 * 33], s[3 * 33]); o.z = pkh(s[4 * 33], s[5 * 33]); o.w = pkh(s[6 * 33], s[7 * 33]);
        *(u32x4*)(WT + (size_t)(drow0 + n) * K + k0 + 8 * c) = o; }
    asm volatile("s_waitcnt lgkmcnt(0)" ::: "memory");
}
__device__ __forceinline__ int glu_row(int n, int half) { const int s = n >= half ? 1 : 0; const int j = n - s * half; return 256 * (j >> 7) + 128 * s + (j & 127); }

__device__ __forceinline__ void sincos_d(double a, float& sn, float& cs) {
    const double q = __builtin_rint(a * 0.63661977236758134308);
    double r = __builtin_fma(-q, 1.57079632679489655800e+00, a); r = __builtin_fma(-q, 6.12323399573676603587e-17, r);
    const double r2 = r * r;
    double s = -7.6471637318198164759e-13; s = s * r2 + 1.6059043836821614599e-10; s = s * r2 - 2.5052108385441718775e-08; s = s * r2 + 2.7557319223985890653e-06;
    s = s * r2 - 1.9841269841269841270e-04; s = s * r2 + 8.3333333333333333333e-03; s = s * r2 - 1.6666666666666666667e-01; s = s * r2 * r + r;
    double c = 4.7794773323873852974e-14; c = c * r2 - 1.1470745597729724714e-11; c = c * r2 + 2.0876756987868098979e-09; c = c * r2 - 2.7557319223985890653e-07;
    c = c * r2 + 2.4801587301587301587e-05; c = c * r2 - 1.3888888888888888889e-03; c = c * r2 + 4.1666666666666666667e-02; c = c * r2 - 0.5; c = c * r2 + 1.0;
    const int qi = (int)(long long)q & 3;
    const double ss = (qi == 0) ? s : (qi == 1) ? c : (qi == 2) ? -s : -c;
    const double cc = (qi == 0) ? c : (qi == 1) ? -s : (qi == 2) ? -c : s;
    sn = (float)ss; cs = (float)cc;
}

__global__ void __launch_bounds__(NWAVES * 64, 2) fwd_kernel(Args args) {
    extern __shared__ __attribute__((aligned(16))) unsigned char lds_raw[];
    LAS unsigned char* lds = (LAS unsigned char*)lds_raw;
    const int tid = threadIdx.x, wave = __builtin_amdgcn_readfirstlane(tid >> 6);
    const int G = gridDim.x, bx = blockIdx.x;
    const int vcu = (G % 8 == 0) ? (bx % 8) * (G / 8) + bx / 8 : bx;
    unsigned char* ws = args.ws;
    const float* x = (const float*)args.in[0]; const float* p = (const float*)args.in[1]; const int* positions = (const int*)args.in[2];
    const float* norm_mix_g = (const float*)args.in[3]; const float* w_in = (const float*)args.in[4]; const float* conv_w = (const float*)args.in[5];
    const float* conv_b = (const float*)args.in[6]; const float* conv_ln_g = (const float*)args.in[7]; const float* conv_ln_b = (const float*)args.in[8];
    const float* w_out = (const float*)args.in[9]; const float* norm_ffn_g = (const float*)args.in[10]; const float* w_ffn_up = (const float*)args.in[11];
    const float* w_ffn_down = (const float*)args.in[12]; const float* norm_ple_g = (const float*)args.in[13]; const float* w_ple_gate = (const float*)args.in[14];
    const float* w_ple_proj = (const float*)args.in[15]; const float* final_norm_g = (const float*)args.in[16];
    float* out = args.out;
    f16_t* Win_t = (f16_t*)(ws + WS_WIN); f16_t* Wout_t = (f16_t*)(ws + WS_WOUT); f16_t* Wup_t = (f16_t*)(ws + WS_WUP); f16_t* Wdn_t = (f16_t*)(ws + WS_WDN);
    f16_t* Wpg_t = (f16_t*)(ws + WS_WPG); f16_t* Wpp_t = (f16_t*)(ws + WS_WPP);
    float* ropec = (float*)(ws + WS_ROPE); float* ropes = (float*)(ws + WS_ROPE + 512 * 1024);
    f16_t* XN = (f16_t*)(ws + WS_XN); f16_t* PP = (f16_t*)(ws + WS_PP); f16_t* HID = (f16_t*)(ws + WS_HID);
    f16_t* P16 = (f16_t*)(ws + WS_P16); f16_t* Ub = (f16_t*)(ws + WS_U); f16_t* Kb = (f16_t*)(ws + WS_K); f16_t* Vb = (f16_t*)(ws + WS_V); f16_t* MIX = (f16_t*)(ws + WS_MIX);
    float* kms = (float*)(ws + WS_CTL + CTL_KMS); float* rss1 = (float*)(ws + WS_CTL + CTL_RSS1); float* rss2 = (float*)(ws + WS_CTL + CTL_RSS2); float* rss3 = (float*)(ws + WS_CTL + CTL_RSS3);

    for (int u = tid; u < (LDS_BYTES - LDSCTL_OFF) / 4; u += NWAVES * 64) ((LAS unsigned*)(lds + LDSCTL_OFF))[u] = 0u;
    __syncthreads();
    XcdBarrier bar; bar.bar = (unsigned*)(ws + WS_CTL + CTL_BAR); bar.x = 0; bar.st = nullptr;
    if (args.ph_hi - args.ph_lo > 1) bar = xcd_barrier_post((unsigned*)(ws + WS_CTL + CTL_BAR), (volatile LAS unsigned*)(lds + MISC_OFF) + 8);
    const int lo = args.ph_lo, hi = args.ph_hi;
#ifndef PHASES
#define PHASES 0xFF
#endif
#define IN(k) ((((PHASES) >> (k)) & 1) && lo <= (k) && (k) < hi)
#define SEAM(k) do { if (IN(k) && IN((k) + 1)) { xcd_barrier(bar); } } while (0)
    const bool dry = args.dry != 0;
    float* dmy_out = (float*)(ws + WS_DUMMY); float* dmy_rss = (float*)(ws + WS_DUMMY + 64 * MiB); f16_t* dmy_mix = (f16_t*)(ws + WS_DUMMY);
    const int gw = vcu * NWAVES + wave, NGW = G * NWAVES;

    if (IN(0)) {
        const int lane = tid & 63;
        LAS float* scr = (LAS float*)(lds + RING_OFF + wave * 16384);
        constexpr int I_IN = (D / 64) * (INW / 32), I_OUT = (D / 64) * (D / 32), I_UP = (D / 64) * (2 * DFF / 32), I_DN = (DFF / 64) * (D / 32), I_PG = I_OUT, I_PP = (PLE / 64) * (D / 32);
        constexpr int NITEMS = I_IN + I_OUT + I_UP + I_DN + I_PG + I_PP;
        for (int it = gw; it < NITEMS; it += NGW) {
            int r = it;
            if (r < I_IN) { const int nblk = INW / 32, kb = r / nblk, nb = r % nblk, n0 = 32 * nb; const int drow = n0 < 2 * CONV_CH ? glu_row(n0, CONV_CH) : n0;
                p0_transpose_item(w_in, D, INW, Win_t, norm_mix_g, scr, 64 * kb, n0, drow, lane); continue; } r -= I_IN;
            if (r < I_OUT) { const int nblk = D / 32, kb = r / nblk, nb = r % nblk; p0_transpose_item(w_out, D, D, Wout_t, nullptr, scr, 64 * kb, 32 * nb, 32 * nb, lane); continue; } r -= I_OUT;
            if (r < I_UP) { const int nblk = 2 * DFF / 32, kb = r / nblk, nb = r % nblk, n0 = 32 * nb; p0_transpose_item(w_ffn_up, D, 2 * DFF, Wup_t, norm_ffn_g, scr, 64 * kb, n0, glu_row(n0, DFF), lane); continue; } r -= I_UP;
            if (r < I_DN) { const int nblk = D / 32, kb = r / nblk, nb = r % nblk; p0_transpose_item(w_ffn_down, DFF, D, Wdn_t, nullptr, scr, 64 * kb, 32 * nb, 32 * nb, lane); continue; } r -= I_DN;
            if (r < I_PG) { const int nblk = D / 32, kb = r / nblk, nb = r % nblk; p0_transpose_item(w_ple_gate, D, D, Wpg_t, norm_ple_g, scr, 64 * kb, 32 * nb, 32 * nb, lane); continue; } r -= I_PG;
            { const int nblk = D / 32, kb = r / nblk, nb = r % nblk; p0_transpose_item(w_ple_proj, PLE, D, Wpp_t, nullptr, scr, 64 * kb, 32 * nb, 32 * nb, lane); }
        }
        for (int m = gw; m < M; m += NGW) {
            const f32x4* xr = (const f32x4*)(x + (size_t)m * D) + lane;
            f32x4 v[4]; float s2 = 0.f;
#pragma unroll
            for (int j = 0; j < 4; ++j) { v[j] = xr[64 * j]; s2 += (v[j][0] * v[j][0] + v[j][1] * v[j][1]) + (v[j][2] * v[j][2] + v[j][3] * v[j][3]); }
            const float rstd = 1.0f / sqrtf(wave_sum(s2) * (1.0f / D) + EPS);
            u32x2* o8 = (u32x2*)(XN + (size_t)m * D) + lane;
#pragma unroll
            for (int j = 0; j < 4; ++j) { u32x2 w; w.x = pkh(v[j][0] * rstd, v[j][1] * rstd); w.y = pkh(v[j][2] * rstd, v[j][3] * rstd); o8[64 * j] = w; }
        }
        for (size_t i = (size_t)(vcu * 512 + tid); i < (size_t)M * PLE / 8; i += (size_t)G * 512) {
            const f32x4 a = *((const f32x4*)p + 2 * i), b = *((const f32x4*)p + 2 * i + 1);
            u32x4 w; w.x = pkh(a[0], a[1]); w.y = pkh(a[2], a[3]); w.z = pkh(b[0], b[1]); w.w = pkh(b[2], b[3]);
            *((u32x4*)P16 + i) = w;
        }
        for (int i = vcu * 512 + tid; i < M * 8; i += G * 512) {
            const int m = i >> 3, f = i & 7;
            const float invf = (f == 0) ? 1.0f : (f == 1) ? 0.1939227432012558f : (f == 2) ? 0.03760603070259094f : (f == 3) ? 0.007292664609849453f : (f == 4) ? 0.0014142135623842478f
                             : (f == 5) ? 0.00027424818836152554f : (f == 6) ? 5.318296098266728e-05f : 1.0313386155758053e-05f;
            const float ang = (float)positions[m] * invf;
            float sn, cs; sincos_d((double)ang, sn, cs);
            ropec[i] = cs; ropes[i] = sn;
        }
    }
    SEAM(0);

    if (IN(1)) {
        { pg8::Gemm g{XN, Win_t, M, INW, D}; pg8::StaticOrder S; S.init(M, INW, G, bx);
          pg8::EpiIn E{Ub, MIX, Kb, Vb, ropec, ropes, kms};
          pg8::gemm_phase<pg8::EpiIn, pg8::StaticOrder, true, true>(lds + RING_OFF, g, S, E); }
        { pg8::Gemm g{P16, Wpp_t, M, D, PLE};
          pg8::StaticOrder S; if (G == 256) S.init(M, D, 128, bx & 127); else S.init(M, D, G, bx);
          pg8::EpiF16 E{PP, D};
          if (G != 256 || bx >= 128) pg8::gemm_phase<pg8::EpiF16, pg8::StaticOrder, true, true>(lds + RING_OFF, g, S, E); }
    }
    SEAM(1);

    if (IN(2)) {
#ifndef NO_ATTN
        const int nattn = BATCH * NHEAD * 4;
        for (int v = vcu; v < nattn; v += G) {
            const int bh = v >> 2, s = v & 3;
            for (int i = 0; i < 2; ++i) {
                const int qb = i == 0 ? 7 - s : s;
                unsigned sel = 0xFFFFFFFFu;
                if (qb > 3) sel = attn_body::moba_select(bh / NHEAD, bh % NHEAD, qb, MIX + AW, kms);
                asm volatile("" : "+v"(sel) :: "memory"); __builtin_amdgcn_sched_barrier(0);
                attn_body::attn_unit<8>(bh / NHEAD, bh % NHEAD, qb, MIX + AW, Kb, Vb, (dry ? dmy_mix : MIX) + AW, sel, (char*)lds_raw);
            }
        }
#endif
#ifndef NO_CONV
        {
            LAS f16_t* ut = (LAS f16_t*)(lds + RING_OFF);
            LAS f16_t* wt = (LAS f16_t*)(lds + RING_OFF + 95 * 1024);
            __syncthreads();
            for (int i = tid; i < 32 * CONV_CH; i += 512) wt[i] = (i < CONVK * CONV_CH) ? (f16_t)conv_w[i] : (f16_t)0.f;
            ut[94 * CONV_CH + tid] = (f16_t)0.f;
            const int lane = tid & 63; const int c0 = lane * 8;
            for (int cu = vcu; cu < M / 64; cu += G) {
                const int t0 = cu * 64; const int tb = t0 & (SEQ - 1);
                __syncthreads();
                for (int i = tid; i < 94 * 64; i += 512) {
                    const int rr = i >> 6, ch = i & 63; const int tok = t0 - 30 + rr;
                    u32x4 v = {0u, 0u, 0u, 0u};
                    if (tb - 30 + rr >= 0) v = *(const u32x4*)(Ub + (size_t)tok * CONV_CH + ch * 8);
                    *(LAS u32x4*)(ut + rr * CONV_CH + ch * 8) = v;
                }
                __syncthreads();
                float acc[8][8];
#pragma unroll
                for (int i = 0; i < 8; ++i)
#pragma unroll
                    for (int e = 0; e < 8; ++e) acc[i][e] = 0.f;
                const LAS f16_t* ub = ut + (wave * 8) * CONV_CH + c0;
                const LAS f16_t* wb = wt + c0;
                f16x8 win[15];
#pragma unroll
                for (int i = 0; i < 7; ++i) win[8 + i] = *(const LAS f16x8*)(ub + i * CONV_CH);
#pragma unroll 1
                for (int jj = 0; jj < 32; jj += 8) {
#pragma unroll
                    for (int i = 0; i < 7; ++i) win[i] = win[8 + i];
#pragma unroll
                    for (int i = 0; i < 8; ++i) win[7 + i] = *(const LAS f16x8*)(ub + (jj + 7 + i) * CONV_CH);
#pragma unroll
                    for (int dj = 0; dj < 8; ++dj) {
                        const f16x8 wj = *(const LAS f16x8*)(wb + (jj + dj) * CONV_CH);
#pragma unroll
                        for (int i = 0; i < 8; ++i)
#pragma unroll
                            for (int e = 0; e < 8; ++e) acc[i][e] += (float)wj[e] * (float)win[dj + i][e];
                    }
                }
                float gam[8], bet[8], cb[8];
#pragma unroll
                for (int e = 0; e < 8; ++e) { gam[e] = conv_ln_g[c0 + e]; bet[e] = conv_ln_b[c0 + e]; cb[e] = conv_b[c0 + e]; }
#pragma unroll
                for (int i = 0; i < 8; ++i) {
                    float s = 0.f;
#pragma unroll
                    for (int e = 0; e < 8; ++e) { acc[i][e] += cb[e]; s += acc[i][e]; }
                    const float mu = wave_sum(s) * (1.0f / CONV_CH);
                    float q = 0.f;
#pragma unroll
                    for (int e = 0; e < 8; ++e) { const float d = acc[i][e] - mu; q += d * d; }
                    const float rstd = 1.0f / sqrtf(wave_sum(q) * (1.0f / CONV_CH) + EPS);
                    float y[8];
#pragma unroll
                    for (int e = 0; e < 8; ++e) { const float z = (acc[i][e] - mu) * rstd * gam[e] + bet[e]; y[e] = z * sigmoidf_(z); }
                    u32x4 w; w.x = pkh(y[0], y[1]); w.y = pkh(y[2], y[3]); w.z = pkh(y[4], y[5]); w.w = pkh(y[6], y[7]);
                    *(u32x4*)(MIX + (size_t)(t0 + wave * 8 + i) * D + c0) = w;
                }
            }
            __syncthreads();
        }
#endif
    }
    SEAM(2);

    if (IN(3)) {
        pg8::Gemm g{MIX, Wout_t, M, D, D}; pg8::StaticOrder S; S.init(M, D, G, bx);
        pg8::EpiRes E{x, dry ? dmy_out : out, XN, dry ? dmy_rss : rss1};
        pg8::gemm_phase<pg8::EpiRes, pg8::StaticOrder, true, true>(lds + RING_OFF, g, S, E);
    }
    SEAM(3);

    if (IN(4)) {
        pg8::Gemm g{XN, Wup_t, M, 2 * DFF, D}; pg8::StaticOrder S; S.init(M, 2 * DFF, G, bx);
        pg8::EpiUp E{HID, rss1};
        pg8::gemm_phase<pg8::EpiUp, pg8::StaticOrder, true, true>(lds + RING_OFF, g, S, E);
    }
    SEAM(4);

    if (IN(5)) {
        pg8::Gemm g{HID, Wdn_t, M, D, DFF}; pg8::StaticOrder S; S.init(M, D, G, bx);
        pg8::EpiRes E{out, dry ? dmy_out : out, XN, dry ? dmy_rss : rss2};
        pg8::gemm_phase<pg8::EpiRes, pg8::StaticOrder, true, true>(lds + RING_OFF, g, S, E);
    }
    SEAM(5);

    if (IN(6)) {
        pg8::Gemm g{XN, Wpg_t, M, D, D}; pg8::StaticOrder S; S.init(M, D, G, bx);
        pg8::EpiGate E{out, dry ? dmy_out : out, PP, rss2, dry ? dmy_rss : rss3};
        pg8::gemm_phase<pg8::EpiGate, pg8::StaticOrder, true, true>(lds + RING_OFF, g, S, E);
    }
    SEAM(6);

    if (IN(7)) {
        int t7_ = threadIdx.x; asm volatile("" : "+v"(t7_)); const int lane = t7_ & 63;
        f32x4 gv[4];
#pragma unroll
        for (int j = 0; j < 4; ++j) gv[j] = *((const f32x4*)final_norm_g + lane + 64 * j);
        for (int m = gw; m < M; m += NGW) {
            const float rs = 1.0f / sqrtf(rss3[m] * (1.0f / D) + EPS);
            const f32x4* xr = (const f32x4*)(out + (size_t)m * D) + lane; f32x4* yr = (f32x4*)((dry ? dmy_out : out) + (size_t)m * D) + lane;
#pragma unroll
            for (int j = 0; j < 4; ++j) { f32x4 v = xr[64 * j]; v = v * rs * gv[j]; yr[64 * j] = v; }
        }
    }
#undef IN
#undef SEAM
}

extern "C" void kernel_launch(void* const* d_in, const int* in_sizes, int n_in, void* d_out, int out_size, void* d_ws, size_t ws_size, hipStream_t stream) {
    static int grid = 0;
    if (grid == 0) {
        if (n_in != 17 || out_size != M * D || ws_size < WS_END + 65 * MiB) { fprintf(stderr, "kernel_launch: unexpected shapes (n_in %d, out %d, ws %zu)\n", n_in, out_size, ws_size); grid = -1; return; }
        int dev = 0, cus = 0, per_cu = 0;
        if (hipGetDevice(&dev) != hipSuccess || hipDeviceGetAttribute(&cus, hipDeviceAttributeMultiprocessorCount, dev) != hipSuccess) { grid = -1; return; }
        if (hipFuncSetAttribute((const void*)fwd_kernel, hipFuncAttributeMaxDynamicSharedMemorySize, LDS_BYTES) != hipSuccess) { fprintf(stderr, "kernel_launch: hipFuncSetAttribute failed\n"); grid = -1; return; }
        if (hipOccupancyMaxActiveBlocksPerMultiprocessor(&per_cu, (const void*)fwd_kernel, NWAVES * 64, LDS_BYTES) != hipSuccess || per_cu < 1) { fprintf(stderr, "kernel_launch: occupancy query says %d\n", per_cu); per_cu = 1; }
        (void)hipGetLastError();
        grid = cus;
    }
    if (grid < 0) return;
    (void)hipMemsetAsync((char*)d_ws + WS_CTL, 0, CTL_ZERO_BYTES, stream);
    Args a{};
    for (int i = 0; i < 17; ++i) a.in[i] = d_in[i];
    a.out = (float*)d_out; a.ws = (unsigned char*)d_ws;
#ifndef MK_ONE_LAUNCH
#ifndef PROBE_MASK
#define PROBE_MASK 0
#endif
#ifndef PROBE_REPS
#define PROBE_REPS 1
#endif
    for (int ph = 0; ph < 8; ++ph) {
        a.ph_lo = ph; a.ph_hi = ph + 1;
        if ((PROBE_MASK >> ph) & 1) for (int r = 0; r < PROBE_REPS; ++r) { a.dry = 1; hipLaunchKernelGGL(fwd_kernel, dim3(grid), dim3(NWAVES * 64), LDS_BYTES, stream, a); }
        a.dry = 0;
        hipLaunchKernelGGL(fwd_kernel, dim3(grid), dim3(NWAVES * 64), LDS_BYTES, stream, a);
    }
#else
    a.ph_lo = 0; a.ph_hi = 8;
    void* kargs[] = {&a};
    hipError_t e = hipLaunchCooperativeKernel((const void*)fwd_kernel, dim3(grid), dim3(NWAVES * 64), kargs, LDS_BYTES, stream);
    if (e != hipSuccess) fprintf(stderr, "cooperative launch failed: %s (grid %d)\n", hipGetErrorString(e), grid);
#endif
}
```

```cpp
#include <hip/hip_runtime.h>
#include <hip/hip_cooperative_groups.h>
#include <cstdio>
#include <cstdint>
#include <cmath>
namespace cg = cooperative_groups;
#ifndef MK_MULTI_LAUNCH
#define MK_ONE_LAUNCH 1
#endif

#define LAS __attribute__((address_space(3)))
#define GAS __attribute__((address_space(1)))
typedef _Float16 f16_t;
typedef _Float16 f16x8 __attribute__((ext_vector_type(8)));
typedef _Float16 f16x4 __attribute__((ext_vector_type(4)));
typedef _Float16 f16x2 __attribute__((ext_vector_type(2)));
typedef float f32x2 __attribute__((ext_vector_type(2)));
typedef float f32x4 __attribute__((ext_vector_type(4)));
typedef float f32x16 __attribute__((ext_vector_type(16)));
typedef unsigned u32x4 __attribute__((ext_vector_type(4)));
typedef unsigned u32x2 __attribute__((ext_vector_type(2)));

constexpr int BATCH = 8, SEQ = 2048, D = 1024, M = BATCH * SEQ;
constexpr int CONV_CH = 512, NHEAD = 8, HD = 64, AW = 512, INW = 2560, DFF = 2816, PLE = 256, CONVK = 31, MOBA = 256, NBLK = SEQ / MOBA;
constexpr float EPS = 1e-6f;
constexpr float LOG2E = 1.4426950408889634f;
constexpr float C2 = 0.125f * 1.4426950408889634f;

__device__ __forceinline__ unsigned pkh(float lo, float hi) { f32x2 v = {lo, hi}; f16x2 h = __builtin_convertvector(v, f16x2); return __builtin_bit_cast(unsigned, h); }
__device__ __forceinline__ float sigmoidf_(float x) { return __builtin_amdgcn_rcpf(1.0f + __builtin_amdgcn_exp2f(-x * LOG2E)); }

namespace pg8 {
constexpr int BM = 256, BK = 64, HALF = 128, HTB = HALF * BK * 2, STAGE_BYTES = 8 * HTB, NXCD = 8, WGM = 8;
__host__ __device__ __forceinline__ int lds_byte(int r, int c) { const int st = (r >> 4) * 2 + (c >> 5), rr = r & 15, cc = c & 31, ob = rr * 64 + cc * 2; return st * 1024 + (ob ^ (((ob >> 9) & 1) << 5)); }
__host__ __device__ __forceinline__ void stage_rc(int b, int& R, int& C) { const int st = b / 1024, sb = b % 1024, swz = sb ^ (((sb >> 9) & 1) << 5); R = (st >> 1) * 16 + swz / 64; C = (st & 1) * 32 + (swz % 64) / 2; }
__host__ __device__ __forceinline__ int perm32(int rho) { const int n = rho >> 4, i = rho & 15; return 8 * (i >> 2) + 4 * n + (i & 3); }

__device__ __forceinline__ void glds16s(unsigned voff, const void* sbase, unsigned lds_dst) { unsigned keep;
    asm volatile("s_mov_b32 %0, m0\n\ts_mov_b32 m0, %3\n\ts_nop 0\n\tglobal_load_lds_dwordx4 %1, %2\n\ts_mov_b32 m0, %0" : "=&s"(keep) : "v"(voff), "s"(sbase), "s"(lds_dst) : "memory"); }
struct Unit { int pm, pn; };
struct Gemm { const f16_t* A; const f16_t* Bt; int M, N, K; };

struct StaticOrder {
    int nM, nN, nwg, G, c;
    __host__ __device__ void init(int M_, int N_, int G_, int c_) { nM = M_ / BM; nN = N_ / BM; nwg = nM * nN; G = G_; c = c_; }
    __host__ __device__ bool next(int i, Unit& u) const {
        const long L = (long)i * G + c; if (L >= nwg) return false;
        int wgid = (int)L; { const int q = nwg / NXCD, r = nwg % NXCD, xcd = wgid % NXCD, off = wgid / NXCD; wgid = (xcd < r ? xcd * (q + 1) : r * (q + 1) + (xcd - r) * q) + off; }
        const int nig = WGM * nN, gid = wgid / nig, fm = gid * WGM, gsz = (nM - fm) < WGM ? (nM - fm) : WGM;
        u.pm = fm + ((wgid % nig) % gsz); u.pn = (wgid % nig) / gsz; return true;
    }
    __device__ __forceinline__ void a_ready(const Unit&) const {}
    __device__ __forceinline__ void done(const Unit&) const {}
};
struct ListOrder {
    int first, count, nN;
    __device__ __forceinline__ bool next(int i, Unit& u) const { if (i >= count) return false; const int L = first + i; u.pm = L / nN; u.pn = L % nN; return true; }
    __device__ __forceinline__ void a_ready(const Unit&) const {}
    __device__ __forceinline__ void done(const Unit&) const {}
};


struct EpiIn {
    static constexpr bool PERM = true, AFTER_DRAIN = false;
    f16_t* U; f16_t* MIX; f16_t* Kb; f16_t* Vb; const float* ropec; const float* ropes; float* kms;
    __device__ __forceinline__ void operator()(const f32x4 (&acc)[2][2][4][2], const Unit& u, int wr, int wc, int fr_, int fq_) const {
        int t_ = threadIdx.x; asm volatile("" : "+v"(t_)); const int fr = t_ & 15, fq = (t_ >> 4) & 3;
        const int row0 = u.pm * BM + wr * 64 + fr;
        const int cw = wc * 32 + 8 * fq;
        if (u.pn < 4) {
#pragma unroll
            for (int ai = 0; ai < 2; ++ai)
#pragma unroll
                for (int m = 0; m < 4; ++m) {
                    const int row = row0 + ai * HALF + m * 16;
                    const f32x4 a0 = acc[ai][0][m][0], a1 = acc[ai][0][m][1], g0 = acc[ai][1][m][0], g1 = acc[ai][1][m][1];
                    u32x4 w;
                    w.x = pkh(a0[0] * sigmoidf_(g0[0]), a0[1] * sigmoidf_(g0[1])); w.y = pkh(a0[2] * sigmoidf_(g0[2]), a0[3] * sigmoidf_(g0[3]));
                    w.z = pkh(a1[0] * sigmoidf_(g1[0]), a1[1] * sigmoidf_(g1[1])); w.w = pkh(a1[2] * sigmoidf_(g1[2]), a1[3] * sigmoidf_(g1[3]));
                    *(u32x4*)(U + (size_t)row * CONV_CH + 128 * u.pn + cw) = w;
                }
        } else if (u.pn < 8) {
            const bool isq = u.pn < 6;
            const int ct = (u.pn - (isq ? 4 : 6)) * 256;
            const bool ropew = (wc & 1) == 0;
            const float sgn = (fq == 0) ? -1.f : 1.f;
            const bool ropel = fq < 2;
            float cs[2][8];
#pragma unroll
            for (int bj = 0; bj < 2; ++bj)
#pragma unroll
                for (int e = 0; e < 8; ++e) cs[bj][e] = 0.f;
#pragma unroll
            for (int ai = 0; ai < 2; ++ai)
#pragma unroll
                for (int m = 0; m < 4; ++m) {
                    const int row = row0 + ai * HALF + m * 16;
                    f32x4 c0 = {1.f, 1.f, 1.f, 1.f}, c1 = c0, s0 = {0.f, 0.f, 0.f, 0.f}, s1 = s0;
                    if (ropew) { c0 = *(const f32x4*)(ropec + (size_t)row * 8); c1 = *(const f32x4*)(ropec + (size_t)row * 8 + 4); s0 = *(const f32x4*)(ropes + (size_t)row * 8); s1 = *(const f32x4*)(ropes + (size_t)row * 8 + 4); }
#pragma unroll
                    for (int bj = 0; bj < 2; ++bj) {
                        f32x4 v0 = acc[ai][bj][m][0], v1 = acc[ai][bj][m][1];
                        if (ropew) {
                            f32x4 p0, p1;
#pragma unroll
                            for (int e = 0; e < 4; ++e) { p0[e] = __shfl_xor(v0[e], 16); p1[e] = __shfl_xor(v1[e], 16); }
                            if (ropel) { v0 = v0 * c0 + (p0 * s0) * sgn; v1 = v1 * c1 + (p1 * s1) * sgn; }
                        }
                        if (isq) {
                            v0 = v0 * C2; v1 = v1 * C2;
                            u32x4 w; w.x = pkh(v0[0], v0[1]); w.y = pkh(v0[2], v0[3]); w.z = pkh(v1[0], v1[1]); w.w = pkh(v1[2], v1[3]);
                            *(u32x4*)(MIX + (size_t)row * D + AW + ct + bj * HALF + cw) = w;
                        } else {
#pragma unroll
                            for (int e = 0; e < 4; ++e) { cs[bj][e] += v0[e]; cs[bj][4 + e] += v1[e]; }
                            u32x4 w; w.x = pkh(v0[0], v0[1]); w.y = pkh(v0[2], v0[3]); w.z = pkh(v1[0], v1[1]); w.w = pkh(v1[2], v1[3]);
                            *(u32x4*)(Kb + (size_t)row * AW + ct + bj * HALF + cw) = w;
                        }
                    }
                    asm volatile("" ::: "memory");
                }
            if (!isq) {
#pragma unroll
                for (int bj = 0; bj < 2; ++bj)
#pragma unroll
                    for (int e = 0; e < 8; ++e) { float s = cs[bj][e]; s += __shfl_xor(s, 1); s += __shfl_xor(s, 2); s += __shfl_xor(s, 4); s += __shfl_xor(s, 8); cs[bj][e] = s; }
                if (fr == 0) {
#pragma unroll
                    for (int bj = 0; bj < 2; ++bj)
#pragma unroll
                        for (int e = 0; e < 8; ++e) atomicAdd(kms + (size_t)u.pm * AW + ct + bj * HALF + cw + e, cs[bj][e]);
                }
            }
        } else {
            const int ct = (u.pn - 8) * 256;
#pragma unroll
            for (int ai = 0; ai < 2; ++ai)
#pragma unroll
                for (int m = 0; m < 4; ++m) {
                    const int row = row0 + ai * HALF + m * 16;
#pragma unroll
                    for (int bj = 0; bj < 2; ++bj) {
                        const f32x4 v0 = acc[ai][bj][m][0], v1 = acc[ai][bj][m][1];
                        u32x4 w; w.x = pkh(v0[0], v0[1]); w.y = pkh(v0[2], v0[3]); w.z = pkh(v1[0], v1[1]); w.w = pkh(v1[2], v1[3]);
                        *(u32x4*)(Vb + (size_t)row * AW + ct + bj * HALF + cw) = w;
                    }
                }
        }
    }
};
struct EpiF16 {
    static constexpr bool PERM = true, AFTER_DRAIN = false;
    f16_t* O; int ldc;
    __device__ __forceinline__ void operator()(const f32x4 (&acc)[2][2][4][2], const Unit& u, int wr, int wc, int fr_, int fq_) const {
        int t_ = threadIdx.x; asm volatile("" : "+v"(t_)); const int fr = t_ & 15, fq = (t_ >> 4) & 3;
        const int row0 = u.pm * BM + wr * 64 + fr; const int col0 = u.pn * BM + wc * 32 + 8 * fq;
#pragma unroll
        for (int ai = 0; ai < 2; ++ai)
#pragma unroll
            for (int m = 0; m < 4; ++m) { f16_t* rowp = O + (size_t)(row0 + ai * HALF + m * 16) * ldc + col0;
#pragma unroll
                for (int bj = 0; bj < 2; ++bj) { const f32x4 v0 = acc[ai][bj][m][0], v1 = acc[ai][bj][m][1];
                    u32x4 w; w.x = pkh(v0[0], v0[1]); w.y = pkh(v0[2], v0[3]); w.z = pkh(v1[0], v1[1]); w.w = pkh(v1[2], v1[3]);
                    *(u32x4*)(rowp + bj * HALF) = w; } }
    }
};
template <bool BASE16> struct EpiRes {
    static constexpr bool PERM = true, AFTER_DRAIN = false;
    const void* base; f16_t* An; float* rowss;
    __device__ __forceinline__ void operator()(const f32x4 (&acc)[2][2][4][2], const Unit& u, int wr, int wc, int fr_, int fq_) const {
        int t_ = threadIdx.x; asm volatile("" : "+v"(t_)); const int fr = t_ & 15, fq = (t_ >> 4) & 3;
        const int col0 = u.pn * BM + wc * 32 + 8 * fq;
#pragma unroll
        for (int ai = 0; ai < 2; ++ai)
#pragma unroll
            for (int m = 0; m < 4; ++m) {
                const int r = u.pm * BM + ai * HALF + wr * 64 + m * 16 + fr; const size_t off = (size_t)r * D + col0;
                float ss = 0.f;
#pragma unroll
                for (int bj = 0; bj < 2; ++bj) {
                    f32x4 b0, b1;
                    if (BASE16) { const f16x8 hb = *(const f16x8*)((const f16_t*)base + off + bj * HALF);
                        b0 = (f32x4){(float)hb[0], (float)hb[1], (float)hb[2], (float)hb[3]}; b1 = (f32x4){(float)hb[4], (float)hb[5], (float)hb[6], (float)hb[7]}; }
                    else { b0 = *(const f32x4*)((const float*)base + off + bj * HALF); b1 = *(const f32x4*)((const float*)base + off + bj * HALF + 4); }
                    const f32x4 o0 = b0 + acc[ai][bj][m][0], o1 = b1 + acc[ai][bj][m][1];
                    ss += (o0[0] * o0[0] + o0[1] * o0[1]) + (o0[2] * o0[2] + o0[3] * o0[3]) + (o1[0] * o1[0] + o1[1] * o1[1]) + (o1[2] * o1[2] + o1[3] * o1[3]);
                    u32x4 w; w.x = pkh(o0[0], o0[1]); w.y = pkh(o0[2], o0[3]); w.z = pkh(o1[0], o1[1]); w.w = pkh(o1[2], o1[3]);
                    *(u32x4*)(An + off + bj * HALF) = w;
                }
                ss += __shfl_xor(ss, 16); ss += __shfl_xor(ss, 32);
                if (fq == 0) atomicAdd(rowss + r, ss);
            }
    }
};
struct EpiUp {
    static constexpr bool PERM = true, AFTER_DRAIN = false;
    f16_t* Hd; const float* rowss;
    __device__ __forceinline__ void operator()(const f32x4 (&acc)[2][2][4][2], const Unit& u, int wr, int wc, int fr_, int fq_) const {
        int t_ = threadIdx.x; asm volatile("" : "+v"(t_)); const int fr = t_ & 15, fq = (t_ >> 4) & 3;
        const int row0 = u.pm * BM + wr * 64 + fr; const int col0 = u.pn * HALF + wc * 32 + 8 * fq;
#pragma unroll
        for (int ai = 0; ai < 2; ++ai)
#pragma unroll
            for (int m = 0; m < 4; ++m) {
                const int row = row0 + ai * HALF + m * 16;
                const float rs = 1.0f / sqrtf(rowss[row] * (1.0f / D) + EPS);
                float h[8];
#pragma unroll
                for (int n = 0; n < 2; ++n)
#pragma unroll
                    for (int e = 0; e < 4; ++e) { const float g = acc[ai][0][m][n][e] * rs, up = acc[ai][1][m][n][e] * rs; h[4 * n + e] = g * sigmoidf_(g) * up; }
                u32x4 w; w.x = pkh(h[0], h[1]); w.y = pkh(h[2], h[3]); w.z = pkh(h[4], h[5]); w.w = pkh(h[6], h[7]);
                *(u32x4*)(Hd + (size_t)row * DFF + col0) = w;
            }
    }
};
struct EpiGate {
    static constexpr bool PERM = true, AFTER_DRAIN = false;
    const f16_t* base; float* out; const f16_t* PP; const float* rowss_in; float* rowss_out;
    __device__ __forceinline__ void operator()(const f32x4 (&acc)[2][2][4][2], const Unit& u, int wr, int wc, int fr_, int fq_) const {
        int t_ = threadIdx.x; asm volatile("" : "+v"(t_)); const int fr = t_ & 15, fq = (t_ >> 4) & 3;
        const int col0 = u.pn * BM + wc * 32 + 8 * fq;
#pragma unroll
        for (int ai = 0; ai < 2; ++ai)
#pragma unroll
            for (int m = 0; m < 4; ++m) {
                const int r = u.pm * BM + ai * HALF + wr * 64 + m * 16 + fr; const size_t off = (size_t)r * D + col0;
                const float rs = 1.0f / sqrtf(rowss_in[r] * (1.0f / D) + EPS);
                float ss = 0.f;
#pragma unroll
                for (int bj = 0; bj < 2; ++bj) {
                    const f16x8 hb = *(const f16x8*)(base + off + bj * HALF);
                    const f16x8 pp = *(const f16x8*)(PP + off + bj * HALF);
                    const f32x4 a0 = acc[ai][bj][m][0] * rs, a1 = acc[ai][bj][m][1] * rs;
                    f32x4 o0, o1;
#pragma unroll
                    for (int e = 0; e < 4; ++e) { o0[e] = (float)hb[e] + sigmoidf_(a0[e]) * (float)pp[e]; o1[e] = (float)hb[4 + e] + sigmoidf_(a1[e]) * (float)pp[4 + e]; }
                    *(f32x4*)(out + off + bj * HALF) = o0; *(f32x4*)(out + off + bj * HALF + 4) = o1;
                    ss += (o0[0] * o0[0] + o0[1] * o0[1]) + (o0[2] * o0[2] + o0[3] * o0[3]) + (o1[0] * o1[0] + o1[1] * o1[1]) + (o1[2] * o1[2] + o1[3] * o1[3]);
                }
                ss += __shfl_xor(ss, 16); ss += __shfl_xor(ss, 32);
                if (fq == 0) atomicAdd(rowss_out + r, ss);
            }
    }
};

template <class Epi, class Sched, bool ALIGN_EPI = false, bool SP2 = false>
__device__ __forceinline__ void gemm_phase(LAS unsigned char* lds, const Gemm g, const Sched& S, const Epi& E) {
    const int tid = threadIdx.x, wid = __builtin_amdgcn_readfirstlane(tid >> 6), lane = tid & 63, wr = wid >> 2, wc = wid & 3, fr = lane & 15, fq = lane >> 4;
    const int K = g.K, nt = K / BK;
    unsigned voffA[2], voffB[2];
#pragma unroll
    for (int i = 0; i < 2; ++i) { int R, C; stage_rc(tid * 16 + i * 8192, R, C); const int Rb = Epi::PERM ? ((R & ~31) + perm32(R & 31)) : R;
        voffA[i] = (unsigned)(R * K + C) * 2u; voffB[i] = (unsigned)(Rb * K + C) * 2u; }
    const size_t kstep = (size_t)(BK * 2);
    const size_t hstep = (size_t)HALF * K * 2;
    const size_t tstep = 2 * hstep;
    const unsigned ldsw = (unsigned)wid * 1024u;
    const unsigned ldsb = (unsigned)(uintptr_t)lds;
    const int aoff = lds_byte(wr * 64 + fr, fq * 8), boff = lds_byte(wc * 32 + fr, fq * 8);
#define PG8_SA(b, h) (((b) * 2 + (h)) * HTB)
#define PG8_SB(b, h) ((4 + (b) * 2 + (h)) * HTB)
#define PG8_STAGE(bufoff, gbase, voff) do { _Pragma("unroll") for (int _i = 0; _i < 2; ++_i) \
        glds16s((voff)[_i], (const void*)(gbase), (unsigned)__builtin_amdgcn_readfirstlane(ldsb + (unsigned)(bufoff) + ldsw + _i * 8192u)); } while (0)
#define PG8_LDA(dst, b, h) do { _Pragma("unroll") for (int m = 0; m < 4; ++m) _Pragma("unroll") for (int k = 0; k < 2; ++k) dst[m][k] = *(const LAS f16x8*)(lds + PG8_SA(b, h) + aoff + m * 2048 + k * 1024); } while (0)
#define PG8_LDB(dst, b, h) do { _Pragma("unroll") for (int n = 0; n < 2; ++n) _Pragma("unroll") for (int k = 0; k < 2; ++k) dst[n][k] = *(const LAS f16x8*)(lds + PG8_SB(b, h) + boff + n * 2048 + k * 1024); } while (0)
#define PG8_MMA(ai, bj, At, Bt) do { __builtin_amdgcn_s_setprio(1); _Pragma("unroll") for (int m = 0; m < 4; ++m) _Pragma("unroll") for (int n = 0; n < 2; ++n) _Pragma("unroll") for (int k = 0; k < 2; ++k) \
        acc[ai][bj][m][n] = __builtin_amdgcn_mfma_f32_16x16x32_f16(Bt[n][k], At[m][k], acc[ai][bj][m][n], 0, 0, 0); __builtin_amdgcn_s_setprio(0); } while (0)
#define PG8_WAIT_V(n) asm volatile("s_waitcnt vmcnt(" #n ")" ::: "memory")
#define PG8_WAIT_L(n) asm volatile("s_waitcnt lgkmcnt(" #n ")" ::: "memory")
#define PG8_BAR __builtin_amdgcn_s_barrier()
#define PG8_SCHED __builtin_amdgcn_sched_barrier(0)
    Unit cur, nxt; int ui = 0;
    if (!S.next(0, cur)) return;
    f32x4 acc[2][2][4][2];
#pragma unroll
    for (int a = 0; a < 2; ++a)
#pragma unroll
        for (int b = 0; b < 2; ++b)
#pragma unroll
            for (int m = 0; m < 4; ++m)
#pragma unroll
                for (int n = 0; n < 2; ++n) acc[a][b][m][n] = (f32x4){0.f, 0.f, 0.f, 0.f};
    f16x8 At[4][2], B0[2][2], B1[2][2];
    const char* cA = (const char*)g.A + (size_t)cur.pm * tstep; const char* cB = (const char*)g.Bt + (size_t)cur.pn * tstep;
    S.a_ready(cur);
    if constexpr (SP2) {
        PG8_STAGE(PG8_SB(0, 0), cB, voffB); PG8_STAGE(PG8_SB(0, 1), cB + hstep, voffB); PG8_STAGE(PG8_SA(0, 0), cA, voffA); PG8_STAGE(PG8_SA(0, 1), cA + hstep, voffA);
        if (wr == 1) PG8_BAR;
        PG8_WAIT_V(2); PG8_BAR;
        PG8_STAGE(PG8_SB(1, 0), cB + kstep, voffB); PG8_STAGE(PG8_SA(1, 0), cA + kstep, voffA); PG8_STAGE(PG8_SB(1, 1), cB + hstep + kstep, voffB);
        PG8_WAIT_V(6); PG8_BAR;
    } else {
        PG8_STAGE(PG8_SB(0, 0), cB, voffB); PG8_STAGE(PG8_SA(0, 0), cA, voffA); PG8_STAGE(PG8_SB(0, 1), cB + hstep, voffB); PG8_STAGE(PG8_SA(0, 1), cA + hstep, voffA);
        if (wr == 1) PG8_BAR;
        PG8_WAIT_V(4); PG8_BAR;
        PG8_STAGE(PG8_SB(1, 0), cB + kstep, voffB); PG8_STAGE(PG8_SA(1, 0), cA + kstep, voffA); PG8_STAGE(PG8_SB(1, 1), cB + hstep + kstep, voffB);
        PG8_WAIT_V(6); PG8_BAR;
    }
    for (;;) {
        const bool has_next = S.next(ui + 1, nxt);
        const char* nA = has_next ? (const char*)g.A + (size_t)nxt.pm * tstep : cA; const char* nB = has_next ? (const char*)g.Bt + (size_t)nxt.pn * tstep : cB;
        for (int t = 0; t < nt; t += 2) {
            const bool last = (t == nt - 2);
            const char* a1 = cA + (size_t)(t + 1) * kstep;
            const char* a2 = last ? nA : cA + (size_t)(t + 2) * kstep; const char* b2 = last ? nB : cB + (size_t)(t + 2) * kstep;
            const char* a3 = a2 + kstep; const char* b3 = b2 + kstep;
            if (last && has_next) S.a_ready(nxt);
            if constexpr (SP2) {
            PG8_LDB(B0, 0, 0); PG8_LDB(B1, 0, 1); PG8_SCHED; PG8_LDA(At, 0, 0); PG8_STAGE(PG8_SA(1, 1), a1 + hstep, voffA);
            PG8_WAIT_V(8); PG8_WAIT_L(0); PG8_BAR; PG8_MMA(0, 0, At, B0); PG8_MMA(0, 1, At, B1); PG8_BAR; PG8_SCHED;
            PG8_LDA(At, 0, 1); PG8_STAGE(PG8_SB(0, 0), b2, voffB); PG8_STAGE(PG8_SB(0, 1), b2 + hstep, voffB); PG8_STAGE(PG8_SA(0, 0), a2, voffA);
            PG8_WAIT_V(8); PG8_WAIT_L(0); PG8_BAR; PG8_MMA(1, 0, At, B0); PG8_MMA(1, 1, At, B1); PG8_BAR; PG8_SCHED;
            PG8_LDB(B0, 1, 0); PG8_LDB(B1, 1, 1); PG8_SCHED; PG8_LDA(At, 1, 0); PG8_STAGE(PG8_SA(0, 1), a2 + hstep, voffA);
            PG8_WAIT_V(8); PG8_WAIT_L(0); PG8_BAR; PG8_MMA(0, 0, At, B0); PG8_MMA(0, 1, At, B1); PG8_BAR; PG8_SCHED;
            PG8_LDA(At, 1, 1); PG8_STAGE(PG8_SB(1, 0), b3, voffB); PG8_STAGE(PG8_SB(1, 1), b3 + hstep, voffB); PG8_STAGE(PG8_SA(1, 0), a3, voffA);
            PG8_WAIT_V(8); PG8_WAIT_L(0); PG8_BAR; PG8_MMA(1, 0, At, B0); PG8_MMA(1, 1, At, B1); PG8_BAR; PG8_SCHED;
            } else {
            PG8_LDB(B0, 0, 0); PG8_SCHED; PG8_LDA(At, 0, 0); PG8_STAGE(PG8_SA(1, 1), a1 + hstep, voffA);
            PG8_WAIT_L(8); PG8_BAR; PG8_WAIT_L(0); PG8_MMA(0, 0, At, B0); PG8_BAR; PG8_SCHED;
            PG8_LDB(B1, 0, 1); PG8_STAGE(PG8_SB(0, 0), b2, voffB);
            PG8_BAR; PG8_WAIT_L(0); PG8_MMA(0, 1, At, B1); PG8_BAR;
            PG8_LDA(At, 0, 1); PG8_STAGE(PG8_SA(0, 0), a2, voffA);
            PG8_BAR; PG8_WAIT_L(0); PG8_MMA(1, 0, At, B0); PG8_BAR; PG8_SCHED;
            PG8_STAGE(PG8_SB(0, 1), b2 + hstep, voffB);
            PG8_WAIT_V(6); PG8_BAR; PG8_MMA(1, 1, At, B1); PG8_BAR;
            PG8_LDB(B0, 1, 0); PG8_SCHED; PG8_LDA(At, 1, 0); PG8_STAGE(PG8_SA(0, 1), a2 + hstep, voffA);
            PG8_WAIT_L(8); PG8_BAR; PG8_WAIT_L(0); PG8_MMA(0, 0, At, B0); PG8_BAR; PG8_SCHED;
            PG8_LDB(B1, 1, 1); PG8_STAGE(PG8_SB(1, 0), b3, voffB);
            PG8_BAR; PG8_WAIT_L(0); PG8_MMA(0, 1, At, B1); PG8_BAR;
            PG8_LDA(At, 1, 1); PG8_STAGE(PG8_SA(1, 0), a3, voffA);
            PG8_BAR; PG8_WAIT_L(0); PG8_MMA(1, 0, At, B0); PG8_BAR; PG8_SCHED;
            PG8_STAGE(PG8_SB(1, 1), b3 + hstep, voffB);
            PG8_WAIT_V(6); PG8_BAR; PG8_MMA(1, 1, At, B1); PG8_BAR;
            }
        }
        if constexpr (ALIGN_EPI) { if (wr == 0) PG8_BAR; }
        if constexpr (!Epi::AFTER_DRAIN) { E(acc, cur, wr, wc, fr, fq); S.done(cur); }
        if (!has_next) break;
#pragma unroll
        for (int a = 0; a < 2; ++a)
#pragma unroll
            for (int b = 0; b < 2; ++b)
#pragma unroll
                for (int m = 0; m < 4; ++m)
#pragma unroll
                    for (int n = 0; n < 2; ++n) acc[a][b][m][n] = (f32x4){0.f, 0.f, 0.f, 0.f};
        cur = nxt; cA = nA; cB = nB; ++ui;
        if constexpr (ALIGN_EPI) { if (wr == 1) PG8_BAR; }
    }
    PG8_WAIT_V(0);
    if constexpr (!ALIGN_EPI) { if (wr == 0) PG8_BAR; }
    PG8_BAR;
#undef PG8_SA
#undef PG8_SB
#undef PG8_STAGE
#undef PG8_LDA
#undef PG8_LDB
#undef PG8_MMA
#undef PG8_WAIT_V
#undef PG8_WAIT_L
#undef PG8_BAR
#undef PG8_SCHED
}
}

namespace attn_body {
constexpr int NW = 8, QBLK = 32, QB = QBLK * NW, KVBLK = 64;
constexpr int QP = D;
constexpr int KP = AW;
__device__ __forceinline__ int crow(int r, int hi) { return (r & 3) + 8 * (r >> 2) + 4 * hi; }
#define SBAR() __builtin_amdgcn_sched_barrier(0)
__device__ __forceinline__ void cmask(f32x16& p0, f32x16& p1, int jb, int qrel, int hi) {
    const float NEG = -INFINITY; int kb = 64 * jb + 4 * hi;
#pragma unroll
    for (int r = 0; r < 16; ++r) { int kv = kb + (r & 3) + 8 * (r >> 2); if (kv > qrel) p0[r] = NEG; if (kv + 32 > qrel) p1[r] = NEG; }
}
__device__ __forceinline__ void mmask(f32x16& p0, f32x16& p1, bool keep) {
    const float NEG = -INFINITY;
#pragma unroll
    for (int r = 0; r < 16; ++r) { p0[r] = keep ? p0[r] : NEG; p1[r] = keep ? p1[r] : NEG; }
}
constexpr int NSLOT = 3, SLOTB = 8192;
constexpr int LDS_K = 0, LDS_V = NSLOT * SLOTB, LDS_WS = 2 * NSLOT * SLOTB, LDS_OST = LDS_WS + NW * 64 * 4, LDS_BYTES = LDS_OST + NW * 4096;
__device__ __forceinline__ void glds16(const void* gsrc, unsigned lds_dst) { unsigned keep;
    asm volatile("s_mov_b32 %0, m0\n\ts_mov_b32 m0, %2\n\ts_nop 0\n\tglobal_load_lds_dwordx4 %1, off\n\ts_mov_b32 m0, %0" : "=&s"(keep) : "v"(gsrc), "s"(lds_dst) : "memory"); }
__device__ __forceinline__ float max3f(float a, float b, float c) { float r; asm("v_max3_f32 %0, %1, %2, %3" : "=v"(r) : "v"(a), "v"(b), "v"(c)); return r; }
__device__ __forceinline__ float max2f(float a, float b) { float r; asm("v_max_f32_e32 %0, %1, %2" : "=v"(r) : "v"(a), "v"(b)); return r; }
__device__ __forceinline__ float fadd_s(float a, float b) { float r; asm("v_add_f32_e32 %0, %1, %2" : "=v"(r) : "v"(a), "v"(b)); return r; }
__device__ __forceinline__ float fsub_s(float a, float b) { float r; asm("v_sub_f32_e32 %0, %1, %2" : "=v"(r) : "v"(a), "v"(b)); return r; }
#define WAIT_BAR(N) asm volatile("s_waitcnt vmcnt(" #N ") lgkmcnt(0)\n\ts_barrier" ::: "memory")

__device__ __forceinline__ void qkt(f32x16& p0, f32x16& p1, const char* Kslot, const f16x8* qr, const f32x16& negm, int r32, int hi) {
    const char* kb = Kslot + hi * 1024 + r32 * 16;
#pragma unroll
    for (int d0 = 0; d0 < 4; ++d0) {
        const f16x8 b0 = *reinterpret_cast<const f16x8*>(kb + d0 * 2048);
        const f16x8 b1 = *reinterpret_cast<const f16x8*>(kb + d0 * 2048 + 512);
        if (d0 == 0) { p0 = __builtin_amdgcn_mfma_f32_32x32x16_f16(b0, qr[0], negm, 0, 0, 0); p1 = __builtin_amdgcn_mfma_f32_32x32x16_f16(b1, qr[0], negm, 0, 0, 0); }
        else { p0 = __builtin_amdgcn_mfma_f32_32x32x16_f16(b0, qr[d0], p0, 0, 0, 0); p1 = __builtin_amdgcn_mfma_f32_32x32x16_f16(b1, qr[d0], p1, 0, 0, 0); } }
}
typedef __attribute__((address_space(3))) const char* lds_cptr;
typedef short v4i16_t __attribute__((ext_vector_type(4)));
__device__ __forceinline__ void kload8(f16x8* kf, lds_cptr kp) {
    kf[0] = *(const LAS f16x8*)(kp);        kf[1] = *(const LAS f16x8*)(kp + 512);
    kf[2] = *(const LAS f16x8*)(kp + 2048); kf[3] = *(const LAS f16x8*)(kp + 2560);
    kf[4] = *(const LAS f16x8*)(kp + 4096); kf[5] = *(const LAS f16x8*)(kp + 4608);
    kf[6] = *(const LAS f16x8*)(kp + 6144); kf[7] = *(const LAS f16x8*)(kp + 6656);
}
__device__ __forceinline__ void kload2(f16x8* kf, lds_cptr kp, int j) { kf[2 * j] = *(const LAS f16x8*)(kp + j * 2048); kf[2 * j + 1] = *(const LAS f16x8*)(kp + j * 2048 + 512); }
__device__ __forceinline__ f16x4 vtr(lds_cptr p) { return __builtin_bit_cast(f16x4, __builtin_amdgcn_ds_read_tr16_b64_v4i16((LAS v4i16_t*)p)); }
__device__ __forceinline__ float rowmax(const f32x16& p0, const f32x16& p1) {
    float a = max3f(p0[0], p0[1], p1[0]), b = max3f(p0[2], p0[3], p1[1]); a = max3f(a, p1[2], p1[3]);
#pragma unroll
    for (int r = 4; r < 16; r += 4) { a = max3f(a, p0[r], p0[r + 1]); b = max3f(b, p0[r + 2], p0[r + 3]); a = max3f(a, p1[r], p1[r + 1]); b = max3f(b, p1[r + 2], p1[r + 3]); }
    const float m = max2f(a, b);
    auto rr = __builtin_amdgcn_permlane32_swap(__float_as_uint(m), __float_as_uint(m), false, false);
    return max2f(__uint_as_float(rr[0]), __uint_as_float(rr[1]));
}
__device__ __forceinline__ void pv(f32x16* o, int vb, f16x8 pa0, f16x8 pa1, f16x8 pa2, f16x8 pa3) {
#pragma unroll
    for (int d0 = 0; d0 < 2; ++d0) { f16x4 lo[4], hi[4];
#pragma unroll
        for (int ks = 0; ks < 4; ++ks) {
            asm volatile("ds_read_b64_tr_b16 %0,%1 offset:%c2" : "=&v"(lo[ks]) : "v"(vb), "i"(d0 * 4096 + ks * 1024) : "memory");
            asm volatile("ds_read_b64_tr_b16 %0,%1 offset:%c2" : "=&v"(hi[ks]) : "v"(vb), "i"(d0 * 4096 + ks * 1024 + 512) : "memory"); }
        asm volatile("s_waitcnt lgkmcnt(0)" ::: "memory"); SBAR();
#define PK(k) __builtin_shufflevector(lo[k], hi[k], 0, 1, 2, 3, 4, 5, 6, 7)
        o[d0] = __builtin_amdgcn_mfma_f32_32x32x16_f16(pa0, PK(0), o[d0], 0, 0, 0);
        o[d0] = __builtin_amdgcn_mfma_f32_32x32x16_f16(pa1, PK(1), o[d0], 0, 0, 0);
        o[d0] = __builtin_amdgcn_mfma_f32_32x32x16_f16(pa2, PK(2), o[d0], 0, 0, 0);
        o[d0] = __builtin_amdgcn_mfma_f32_32x32x16_f16(pa3, PK(3), o[d0], 0, 0, 0);
#undef PK
    }
}

__device__ __forceinline__ unsigned moba_select(int b, int h, int qb, const f16_t* Q, const float* __restrict__ kms) {
    int tid_ = threadIdx.x; asm volatile("" : "+v"(tid_));
    const int tid = tid_, lane = tid & 63, r32 = lane & 31, hi = lane >> 5; const int wid = __builtin_amdgcn_readfirstlane(tid >> 6);
    const f16_t* Qw = Q + ((long)b * SEQ + qb * QB + wid * QBLK) * QP + h * HD;
    f16x8 qr[4];
#pragma unroll
    for (int d0 = 0; d0 < 4; ++d0) qr[d0] = *reinterpret_cast<const f16x8*>(&Qw[(long)r32 * QP + d0 * 16 + hi * 8]);
    float gsc[7];
#pragma unroll
    for (int j = 0; j < 7; ++j) {
        float s = 0.f;
        if (j < qb) {
            const float* km = kms + (size_t)(b * NBLK + j) * AW + h * HD + hi * 8;
#pragma unroll
            for (int d0 = 0; d0 < 4; ++d0) {
                const f32x4 k0 = *(const f32x4*)(km + d0 * 16), k1 = *(const f32x4*)(km + d0 * 16 + 4);
                s += (float)qr[d0][0] * k0[0] + (float)qr[d0][1] * k0[1] + (float)qr[d0][2] * k0[2] + (float)qr[d0][3] * k0[3];
                s += (float)qr[d0][4] * k1[0] + (float)qr[d0][5] * k1[1] + (float)qr[d0][6] * k1[2] + (float)qr[d0][7] * k1[3];
            }
            s += __shfl_xor(s, 32);
            asm volatile("" ::: "memory");
        } else s = -INFINITY;
        gsc[j] = s;
    }
    unsigned sm = 0u;
#pragma unroll
    for (int j = 0; j < 7; ++j) {
        int cnt = 0;
#pragma unroll
        for (int i = 0; i < 7; ++i) { if (i == j) continue; const bool ahead = (gsc[i] > gsc[j]) || (gsc[i] == gsc[j] && i < j); cnt += ahead ? 1 : 0; }
        if (j < qb && cnt < 3) sm |= (1u << j);
    }
    return sm;
}

template <int THRL> __device__ __forceinline__ void attn_unit(int b, int h, int qb, const f16_t* Q, const f16_t* __restrict__ K, const f16_t* __restrict__ V, f16_t* O, const unsigned selmask, char* shm) {
    int tid_ = threadIdx.x; asm volatile("" : "+v"(tid_));
    const int tid = tid_, lane = tid & 63, r32 = lane & 31, hi = lane >> 5; const int wid = __builtin_amdgcn_readfirstlane(tid >> 6);
    const long rowbase = (long)b * SEQ; const int q0 = qb * QB;
    const f16_t* Qw = Q + (rowbase + q0 + wid * QBLK) * QP + h * HD;
    const f16_t* Kh = K + rowbase * KP + h * HD, *Vh = V + rowbase * KP + h * HD;
    const unsigned lds0 = (unsigned)(uintptr_t)shm;
    float* wsf = (float*)(shm + LDS_WS) + wid * 64;
    const f16_t* ksrc = Kh + (long)lane * KP + wid * 8;
    const f16_t* vsrc = Vh + (long)(16 * (wid & 3) + (lane >> 2)) * KP + (wid >> 2) * 32 + (lane & 3) * 8;
    const unsigned kdst = lds0 + LDS_K + wid * 1024, vdst = lds0 + LDS_V + wid * 1024;
#define DMA_K(t, slot) glds16(ksrc + (long)(t) * KVBLK * KP, (unsigned)__builtin_amdgcn_readfirstlane(kdst + (slot)))
#define DMA_V(t, slot) glds16(vsrc + (long)(t) * KVBLK * KP, (unsigned)__builtin_amdgcn_readfirstlane(vdst + (slot)))
    const int vb0 = (int)(lds0 + LDS_V) + ((lane >> 4) & 1) * 32 + (lane & 3) * 8 + (4 * hi + ((lane & 15) >> 2)) * 64;
    const char* Kbase = shm + LDS_K; f16x8 kf[8];
    const lds_cptr shm3 = (lds_cptr)shm; const lds_cptr kp0 = shm3 + LDS_K + hi * 1024 + r32 * 16; const lds_cptr vp0 = shm3 + LDS_V + ((lane >> 4) & 1) * 32 + (lane & 3) * 8 + (4 * hi + ((lane & 15) >> 2)) * 64;
    const int NT = (q0 + QB) / KVBLK;
    DMA_K(0, 0); DMA_V(0, 0); DMA_K(1, SLOTB);
    f16x8 qr[4];
#pragma unroll
    for (int d0 = 0; d0 < 4; ++d0) qr[d0] = *reinterpret_cast<const f16x8*>(&Qw[(long)r32 * QP + d0 * 16 + hi * 8]);
    const bool maskon = qb > 3;
    float mhat = 0.f, l_reg = 0.f; float z_; asm volatile("v_mov_b32 %0, 0" : "=v"(z_)); f32x16 o[2]; f32x16 negm;
    _Pragma("unroll") for (int r = 0; r < 16; ++r) { o[0][r] = z_; o[1][r] = z_; negm[r] = z_; } asm volatile("" : "+v"(negm));
#define CMASK(P0, P1, t) do { int jb_ = (t) - (NT - 4); if (jb_ >= 0) { int q_ = r32; asm volatile("" : "+v"(q_)); cmask(P0, P1, jb_, wid * QBLK + q_, hi); } else if (maskon) mmask(P0, P1, ((selmask >> ((t) >> 2)) & 1u) != 0u); } while (0)
    bool resc = false;
#define START(P0, P1) do { const float rm = rowmax(P0, P1); resc = false; \
    { const float dl = max2f(rm, -100.f); mhat = fadd_s(mhat, dl); \
      _Pragma("unroll") for (int r = 0; r < 16; ++r) { P0[r] = fsub_s(P0[r], dl); P1[r] = fsub_s(P1[r], dl); } \
      _Pragma("unroll") for (int r = 0; r < 16; ++r) negm[r] = -mhat; asm volatile("" : "+v"(negm)); } \
    _Pragma("unroll") for (int r = 0; r < 16; ++r) P0[r] = __builtin_amdgcn_exp2f(P0[r]); } while (0)
#define RESC() do { if (resc) { asm volatile("s_waitcnt lgkmcnt(0)" ::: "memory"); \
      _Pragma("unroll") for (int d_ = 0; d_ < 2; ++d_) _Pragma("unroll") for (int r = 0; r < 16; ++r) o[d_][r] *= wsf[crow(r, hi)]; } } while (0)
    f32x16 pA0, pA1, pB0, pB1;
    int sl_prev = 0, sl_cur = 0, sl_next = SLOTB;
#define ROT() do { sl_prev = sl_cur; sl_cur = sl_next; sl_next = (sl_next == (NSLOT - 1) * SLOTB) ? 0 : sl_next + SLOTB; } while (0)
    DMA_K(2, 2 * SLOTB);
    WAIT_BAR(3);
    qkt(pA0, pA1, Kbase, qr, negm, r32, hi); asm volatile("s_nop 15\n\ts_nop 7" : "+v"(pA0), "+v"(pA1)); CMASK(pA0, pA1, 0);
    START(pA0, pA1);
    _Pragma("unroll") for (int r = 0; r < 16; ++r) pA1[r] = __builtin_amdgcn_exp2f(pA1[r]);
    WAIT_BAR(0);
    DMA_K(3, 0); DMA_V(1, SLOTB);
    ROT();
    kload8(kf, kp0 + sl_cur);
    WAIT_BAR(2);
    f16x4 vlo[8], vhi[8]; u32x4 pw0, pw1, pw2, pw3;
#define PKW(P, B) pkh(P[B], P[B + 1])
#define PAF(k) __builtin_bit_cast(f16x8, pw##k)
#define VFR(i) __builtin_shufflevector(vlo[i], vhi[i], 0, 1, 2, 3, 4, 5, 6, 7)
#define PIN(x) asm volatile("" : "+v"(x))
#define MX3(a, b, c) __builtin_fmaxf(__builtin_fmaxf((a), (b)), (c))
#define GAPA(MF, A0, A1, A2, A3, W0, W1, PW) do { MF; sacc += A0; sacc += A1; sacc += A2; sacc += A3; PIN(sacc); W0; W1; PIN(PW); SBAR(); } while (0)
#define EX(v) __builtin_amdgcn_exp2f(v)
#define GAPB(MF, X, B) do { MF; X[B] = EX(X[B]); X[B + 1] = EX(X[B + 1]); X[B + 2] = EX(X[B + 2]); X[B + 3] = EX(X[B + 3]); PIN(X); SBAR(); } while (0)
#define VRD(i) do { vlo[i] = vtr(vp_ + (((i) >> 2) * 4096 + ((i) & 3) * 1024)); vhi[i] = vtr(vp_ + (((i) >> 2) * 4096 + ((i) & 3) * 1024 + 512)); } while (0)
#define KRD(G, j) do { if (G) { kload2(kf, kp0 + sl_next, j); SBAR(); } } while (0)
#define MF16(a, b, c) __builtin_amdgcn_mfma_f32_32x32x16_f16(a, b, c, 0, 0, 0)
#define STEP(C0, C1, P0, P1, t, GK, GV, GL) do { SBAR(); \
    const lds_cptr vp_ = vp0 + sl_prev; \
    VRD(0); SBAR(); float sacc = (P0[0] + P0[1]); \
    GAPA(C0 = MF16(kf[0], qr[0], negm), P0[2], P0[3], P0[4], P0[5],     pw0[0] = PKW(P0, 0), pw0[1] = PKW(P0, 2), pw0); \
    VRD(4); SBAR(); GAPA(C1 = MF16(kf[1], qr[0], negm), P0[6], P0[7], P0[8], P0[9],     pw0[2] = PKW(P0, 4), pw0[3] = PKW(P0, 6), pw0); \
    VRD(1); SBAR(); GAPA(C0 = MF16(kf[2], qr[1], C0),   P0[10], P0[11], P0[12], P0[13], pw1[0] = PKW(P0, 8), pw1[1] = PKW(P0, 10), pw1); \
    VRD(5); SBAR(); GAPA(C1 = MF16(kf[3], qr[1], C1),   P0[14], P0[15], P1[0], P1[1],   pw1[2] = PKW(P0, 12), pw1[3] = PKW(P0, 14), pw1); \
    VRD(2); SBAR(); GAPA(C0 = MF16(kf[4], qr[2], C0),   P1[2], P1[3], P1[4], P1[5],     pw2[0] = PKW(P1, 0), pw2[1] = PKW(P1, 2), pw2); \
    VRD(6); SBAR(); GAPA(C1 = MF16(kf[5], qr[2], C1),   P1[6], P1[7], P1[8], P1[9],     pw2[2] = PKW(P1, 4), pw2[3] = PKW(P1, 6), pw2); \
    VRD(3); SBAR(); GAPA(C0 = MF16(kf[6], qr[3], C0),   P1[10], P1[11], P1[12], P1[13], pw3[0] = PKW(P1, 8), pw3[1] = PKW(P1, 10), pw3); \
    VRD(7); SBAR(); GAPA(C1 = MF16(kf[7], qr[3], C1),   P1[14], P1[15], 0.f, 0.f,       pw3[2] = PKW(P1, 12), pw3[3] = PKW(P1, 14), pw3); \
    l_reg += sacc; \
    if (GK) { DMA_K((t) + 3, sl_cur); } if (GV) { DMA_V((t) + 1, sl_next); } \
    CMASK(C0, C1, t); \
    { float a = MX3(C0[0], C0[1], C1[0]), b_ = MX3(C0[2], C0[3], C1[1]); a = MX3(a, C1[2], C1[3]); \
      _Pragma("unroll") for (int r = 4; r < 16; r += 4) { a = MX3(a, C0[r], C0[r + 1]); b_ = MX3(b_, C0[r + 2], C0[r + 3]); a = MX3(a, C1[r], C1[r + 1]); b_ = MX3(b_, C1[r + 2], C1[r + 3]); } \
      float rm = __builtin_fmaxf(a, b_); { auto rr = __builtin_amdgcn_permlane32_swap(__float_as_uint(rm), __float_as_uint(rm), false, false); rm = __builtin_fmaxf(__uint_as_float(rr[0]), __uint_as_float(rr[1])); } \
      resc = false; \
      if (__builtin_expect(__any(rm > (float)THRL), 0)) { const float dl = __builtin_fmaxf(rm, 0.f); mhat += dl; \
        _Pragma("unroll") for (int r = 0; r < 16; ++r) { C0[r] -= dl; C1[r] -= dl; } \
        _Pragma("unroll") for (int r = 0; r < 16; ++r) negm[r] = -mhat; asm volatile("" : "+v"(negm)); \
        const float f = __builtin_amdgcn_exp2f(-dl); l_reg *= f; if (hi == 0) wsf[r32] = f; resc = true; } } \
    SBAR(); \
    GAPB(o[0] = MF16(PAF(0), VFR(0), o[0]), C0, 0); \
    GAPB(o[1] = MF16(PAF(0), VFR(4), o[1]), C0, 4); \
    KRD(GL, 0); GAPB(o[0] = MF16(PAF(1), VFR(1), o[0]), C0, 8); \
    KRD(GL, 1); GAPB(o[1] = MF16(PAF(1), VFR(5), o[1]), C0, 12); \
    KRD(GL, 2); GAPB(o[0] = MF16(PAF(2), VFR(2), o[0]), C1, 0); \
    KRD(GL, 3); GAPB(o[1] = MF16(PAF(2), VFR(6), o[1]), C1, 4); \
    GAPB(o[0] = MF16(PAF(3), VFR(3), o[0]), C1, 8); \
    GAPB(o[1] = MF16(PAF(3), VFR(7), o[1]), C1, 12); \
    } while (0)
    int t = 1;
    for (; t + 5 < NT; t += 2) {
        STEP(pB0, pB1, pA0, pA1, t, true, true, true);     WAIT_BAR(2); RESC(); ROT();
        STEP(pA0, pA1, pB0, pB1, t + 1, true, true, true); WAIT_BAR(2); RESC(); ROT();
    }
#define ENDW(tt) do { if ((tt) + 3 < NT) { WAIT_BAR(2); } else if ((tt) + 2 < NT) { WAIT_BAR(1); } else { WAIT_BAR(0); } } while (0)
    for (; t + 1 < NT; t += 2) {
        STEP(pB0, pB1, pA0, pA1, t, (t + 3 < NT), (t + 1 < NT), (t + 1 < NT));         ENDW(t);     RESC(); ROT();
        STEP(pA0, pA1, pB0, pB1, t + 1, (t + 4 < NT), (t + 2 < NT), (t + 2 < NT));     ENDW(t + 1); RESC(); ROT();
    }
    STEP(pB0, pB1, pA0, pA1, NT - 1, false, false, false); RESC();
    { float sacc = pB0[0] + pB0[1]; _Pragma("unroll") for (int r = 2; r < 16; ++r) sacc += pB0[r]; _Pragma("unroll") for (int r = 0; r < 16; ++r) sacc += pB1[r]; l_reg += sacc;
      pw0 = (u32x4){PKW(pB0, 0), PKW(pB0, 2), PKW(pB0, 4), PKW(pB0, 6)}; pw1 = (u32x4){PKW(pB0, 8), PKW(pB0, 10), PKW(pB0, 12), PKW(pB0, 14)}; pw2 = (u32x4){PKW(pB1, 0), PKW(pB1, 2), PKW(pB1, 4), PKW(pB1, 6)}; pw3 = (u32x4){PKW(pB1, 8), PKW(pB1, 10), PKW(pB1, 12), PKW(pB1, 14)};
      SBAR(); pv(o, vb0 + sl_cur, PAF(0), PAF(1), PAF(2), PAF(3)); }
#undef PKW
#undef PAF
#undef VFR
#undef PIN
#undef MX3
#undef GAPA
#undef GAPB
#undef EX
#undef VRD
#undef KRD
#undef STEP
#undef ENDW
#undef MF16
    { auto rr = __builtin_amdgcn_permlane32_swap(__float_as_uint(l_reg), __float_as_uint(l_reg), false, false); l_reg = __uint_as_float(rr[0]) + __uint_as_float(rr[1]); }
    if (hi == 0) wsf[32 + r32] = l_reg; asm volatile("s_waitcnt lgkmcnt(0)" ::: "memory");
    float rli[16];
#pragma unroll
    for (int r = 0; r < 16; ++r) rli[r] = __builtin_amdgcn_rcpf(wsf[32 + crow(r, hi)]);
    f16_t* Ow = O + (rowbase + q0 + wid * QBLK) * QP + h * HD;
    { f16_t* stg = (f16_t*)(shm + LDS_OST) + wid * 2048;
#pragma unroll
      for (int r = 0; r < 16; ++r) { const int orow = crow(r, hi);
#pragma unroll
        for (int d0 = 0; d0 < 2; ++d0) stg[orow * 64 + d0 * 32 + r32] = (f16_t)(o[d0][r] * rli[r]); }
      asm volatile("s_waitcnt lgkmcnt(0)" ::: "memory");
#pragma unroll
      for (int i = 0; i < 4; ++i) { const int row = i * 8 + (lane >> 3), ch = lane & 7; const u32x4 v = *(const u32x4*)(stg + row * 64 + ch * 8); *(u32x4*)(Ow + (long)row * QP + ch * 8) = v; } }
    asm volatile("s_waitcnt lgkmcnt(0)\n\ts_barrier" ::: "memory");
#undef DMA_K
#undef DMA_V
#undef CMASK
#undef START
#undef RESC
#undef ROT
}
#undef SBAR
#undef WAIT_BAR
}

constexpr int NWAVES = 8;
constexpr size_t MiB = 1u << 20;
constexpr size_t WS_CTL = 0, CTL_ZERO_BYTES = 1 * MiB;
constexpr size_t WS_WIN = 1 * MiB, WS_WOUT = 6 * MiB, WS_WUP = 8 * MiB, WS_WDN = 19 * MiB, WS_WPG = 25 * MiB, WS_WPP = 27 * MiB;
constexpr size_t WS_CW = 27 * MiB + 512 * 1024;
constexpr size_t WS_ROPE = 28 * MiB;
constexpr size_t WS_XN = 29 * MiB;
constexpr size_t WS_PP = 61 * MiB;
constexpr size_t WS_HID = 93 * MiB;
constexpr size_t WS_P16 = 93 * MiB, WS_U = 101 * MiB, WS_K = 117 * MiB, WS_V = 133 * MiB, WS_MIX = 149 * MiB, WS_END = 181 * MiB;
constexpr size_t WS_DUMMY = 181 * MiB;
static_assert(WS_HID + (size_t)M * DFF * 2 <= WS_END && WS_MIX + (size_t)M * D * 2 <= WS_END, "ws map");
constexpr size_t CTL_BAR = 16384;
constexpr size_t CTL_KMS = 64 * 1024;
constexpr size_t CTL_RSS1 = 256 * 1024, CTL_RSS2 = 320 * 1024, CTL_RSS3 = 384 * 1024;
constexpr int RING_OFF = 0, RING_BYTES = 131072;
constexpr int LDSCTL_OFF = RING_BYTES, MISC_OFF = LDSCTL_OFF + 320;
constexpr int LDS_BYTES = 147456;
static_assert(attn_body::LDS_BYTES <= RING_BYTES, "attention LDS");


#define XB_TMO      128
#define XB_XCNT(j)  (256  + 64 * (j))
#define XB_XSUB(j)  (1280 + 64 * (j))
#define XB_XGEN(j)  (2304 + 64 * (j))
#define XB_TOP      3328
#define XB_TOPGEN   3392
#define XCD_BAR_WORDS 3456
#define XB_SPIN_CAP (1u << 18)
__device__ __forceinline__ unsigned xb_ld(unsigned* p)              { return __hip_atomic_load(p, __ATOMIC_RELAXED, __HIP_MEMORY_SCOPE_AGENT); }
__device__ __forceinline__ unsigned xb_add(unsigned* p, unsigned v) { return __hip_atomic_fetch_add(p, v, __ATOMIC_RELAXED, __HIP_MEMORY_SCOPE_AGENT); }
__device__ __forceinline__ unsigned xb_xcc_id() { return (unsigned)__builtin_amdgcn_s_getreg((3 << 11) | 20) & 0xFu; }
#define XB_SPIN(cond, bar) do { unsigned _sp = 0; while (cond) { __builtin_amdgcn_s_sleep(1); \
    if ((++_sp & 255u) == 0u) { if (xb_ld(&(bar)[XB_TMO])) break; if (_sp > XB_SPIN_CAP) { atomicAdd(&(bar)[XB_TMO], 1u); break; } } } } while (0)
struct XcdBarrier { unsigned* bar; unsigned x; volatile LAS unsigned* st; };
__device__ __forceinline__ XcdBarrier xcd_barrier_post(unsigned* bar, volatile LAS unsigned* st) {
    XcdBarrier b; b.bar = bar; b.x = xb_xcc_id(); b.st = st;
    if (threadIdx.x == 0) (void)xb_add(&bar[XB_XCNT(b.x)], 1u);
    return b;
}
__device__ __forceinline__ void xcd_barrier_complete(unsigned* bar, unsigned x, unsigned& nloc, unsigned& nx) {
    const unsigned G = gridDim.x * gridDim.y * gridDim.z;
    unsigned sum, cnt, mine, sp = 0u;
    for (;;) {
        sum = 0u; cnt = 0u; mine = 0u;
#pragma unroll
        for (unsigned j = 0; j < 16; ++j) { const unsigned c = xb_ld(&bar[XB_XCNT(j)]); sum += c; cnt += (c > 0u) ? 1u : 0u; mine = (j == x) ? c : mine; }
        if (sum == G) break;
        __builtin_amdgcn_s_sleep(1);
        if ((++sp & 255u) == 0u) { if (xb_ld(&bar[XB_TMO])) break; if (sp > XB_SPIN_CAP) { atomicAdd(&bar[XB_TMO], 1u); break; } }
    }
    nloc = mine > 0u ? mine : 1u; nx = cnt > 0u ? cnt : 1u;
}
__device__ __forceinline__ void xcd_barrier(const XcdBarrier& b) {
    asm volatile("s_waitcnt vmcnt(0)" ::: "memory");
    __syncthreads();
    if (threadIdx.x == 0) {
        unsigned* bar = b.bar;
        __builtin_amdgcn_s_waitcnt(0);
        unsigned nloc = b.st[0], nx = b.st[1];
        if (nloc == 0u) { xcd_barrier_complete(bar, b.x, nloc, nx); b.st[0] = nloc; b.st[1] = nx; }
        const unsigned old = xb_add(&bar[XB_XSUB(b.x)], 1u);
        const unsigned gen = old / nloc;
        if (old + 1u == (gen + 1u) * nloc) {
            __builtin_amdgcn_fence(__ATOMIC_RELEASE, "agent");
            asm volatile("s_waitcnt vmcnt(0)" ::: "memory");
            const unsigned og = xb_add(&bar[XB_TOP], 1u);
            const unsigned tg = og / nx;
            if (og + 1u == (tg + 1u) * nx) xb_add(&bar[XB_TOPGEN], 1u);
            else XB_SPIN(xb_ld(&bar[XB_TOPGEN]) == tg, bar);
            __builtin_amdgcn_fence(__ATOMIC_ACQUIRE, "agent");
            xb_add(&bar[XB_XGEN(b.x)], 1u);
            asm volatile("s_waitcnt vmcnt(0)" ::: "memory");
        } else {
            XB_SPIN(xb_ld(&bar[XB_XGEN(b.x)]) == gen, bar);
            __builtin_amdgcn_fence(__ATOMIC_ACQUIRE, "agent");
            asm volatile("s_waitcnt vmcnt(0)" ::: "memory");
        }
    }
    __syncthreads();
}

__device__ __forceinline__ float wave_sum(float v) {
#pragma unroll
    for (int o = 1; o < 64; o <<= 1) v += __shfl_xor(v, o);
    return v;
}

struct Args { const void* in[17]; float* out; unsigned char* ws; int ph_lo, ph_hi, dry, pad; };

__device__ __forceinline__ void p0_transpose_item(const float* W, int K, int N, f16_t* WT, const float* gain, LAS float* scr, int k0, int n0, int drow0, int lane) {
#pragma unroll 8
    for (int i = 0; i < 32; ++i) { const int kk = 2 * i + (lane >> 5); float v = W[(size_t)(k0 + kk) * N + n0 + (lane & 31)]; if (gain) v *= gain[k0 + kk]; scr[kk * 33 + (lane & 31)] = v; }
    asm volatile("s_waitcnt lgkmcnt(0)" ::: "memory");
    const int c = lane & 7;
#pragma unroll
    for (int j = 0; j < 4; ++j) { const int n = (lane >> 3) + 8 * j; const LAS float* s = scr + (8 * c) * 33 + n;
        u32x4 o; o.x = pkh(s[0 * 33], s[1 * 33]); o.y = pkh(s[2 * 33], s[3 * 33]); o.z = pkh(s[4 * 33], s[5 * 33]); o.w = pkh(s[6 * 33], s[7 * 33]);
        *(u32x4*)(WT + (size_t)(drow0 + n) * K + k0 + 8 * c) = o; }
    asm volatile("s_waitcnt lgkmcnt(0)" ::: "memory");
}
__device__ __forceinline__ int glu_row(int n, int half) { const int s = n >= half ? 1 : 0; const int j = n - s * half; return 256 * (j >> 7) + 128 * s + (j & 127); }

__device__ __forceinline__ void sincos_d(double a, float& sn, float& cs) {
    const double q = __builtin_rint(a * 0.63661977236758134308);
    double r = __builtin_fma(-q, 1.57079632679489655800e+00, a); r = __builtin_fma(-q, 6.12323399573676603587e-17, r);
    const double r2 = r * r;
    double s = -7.6471637318198164759e-13; s = s * r2 + 1.6059043836821614599e-10; s = s * r2 - 2.5052108385441718775e-08; s = s * r2 + 2.7557319223985890653e-06;
    s = s * r2 - 1.9841269841269841270e-04; s = s * r2 + 8.3333333333333333333e-03; s = s * r2 - 1.6666666666666666667e-01; s = s * r2 * r + r;
    double c = 4.7794773323873852974e-14; c = c * r2 - 1.1470745597729724714e-11; c = c * r2 + 2.0876756987868098979e-09; c = c * r2 - 2.7557319223985890653e-07;
    c = c * r2 + 2.4801587301587301587e-05; c = c * r2 - 1.3888888888888888889e-03; c = c * r2 + 4.1666666666666666667e-02; c = c * r2 - 0.5; c = c * r2 + 1.0;
    const int qi = (int)(long long)q & 3;
    const double ss = (qi == 0) ? s : (qi == 1) ? c : (qi == 2) ? -s : -c;
    const double cc = (qi == 0) ? c : (qi == 1) ? -s : (qi == 2) ? -c : s;
    sn = (float)ss; cs = (float)cc;
}

__global__ void __launch_bounds__(NWAVES * 64, 2) fwd_kernel(Args args) {
    extern __shared__ __attribute__((aligned(16))) unsigned char lds_raw[];
    LAS unsigned char* lds = (LAS unsigned char*)lds_raw;
    const int tid = threadIdx.x, wave = __builtin_amdgcn_readfirstlane(tid >> 6);
    const int G = gridDim.x, bx = blockIdx.x;
    const int vcu = (G % 8 == 0) ? (bx % 8) * (G / 8) + bx / 8 : bx;
    unsigned char* ws = args.ws;
    const float* x = (const float*)args.in[0]; const float* p = (const float*)args.in[1]; const int* positions = (const int*)args.in[2];
    const float* norm_mix_g = (const float*)args.in[3]; const float* w_in = (const float*)args.in[4]; const float* conv_w = (const float*)args.in[5];
    const float* conv_b = (const float*)args.in[6]; const float* conv_ln_g = (const float*)args.in[7]; const float* conv_ln_b = (const float*)args.in[8];
    const float* w_out = (const float*)args.in[9]; const float* norm_ffn_g = (const float*)args.in[10]; const float* w_ffn_up = (const float*)args.in[11];
    const float* w_ffn_down = (const float*)args.in[12]; const float* norm_ple_g = (const float*)args.in[13]; const float* w_ple_gate = (const float*)args.in[14];
    const float* w_ple_proj = (const float*)args.in[15]; const float* final_norm_g = (const float*)args.in[16];
    float* out = args.out;
    f16_t* Win_t = (f16_t*)(ws + WS_WIN); f16_t* Wout_t = (f16_t*)(ws + WS_WOUT); f16_t* Wup_t = (f16_t*)(ws + WS_WUP); f16_t* Wdn_t = (f16_t*)(ws + WS_WDN);
    f16_t* Wpg_t = (f16_t*)(ws + WS_WPG); f16_t* Wpp_t = (f16_t*)(ws + WS_WPP); f16_t* CW16 = (f16_t*)(ws + WS_CW);
    float* ropec = (float*)(ws + WS_ROPE); float* ropes = (float*)(ws + WS_ROPE + 512 * 1024);
    f16_t* XN = (f16_t*)(ws + WS_XN); f16_t* PP = (f16_t*)(ws + WS_PP); f16_t* HID = (f16_t*)(ws + WS_HID);
    f16_t* P16 = (f16_t*)(ws + WS_P16); f16_t* Ub = (f16_t*)(ws + WS_U); f16_t* Kb = (f16_t*)(ws + WS_K); f16_t* Vb = (f16_t*)(ws + WS_V); f16_t* MIX = (f16_t*)(ws + WS_MIX);
    float* kms = (float*)(ws + WS_CTL + CTL_KMS); float* rss1 = (float*)(ws + WS_CTL + CTL_RSS1); float* rss2 = (float*)(ws + WS_CTL + CTL_RSS2); float* rss3 = (float*)(ws + WS_CTL + CTL_RSS3);

    for (int u = tid; u < (LDS_BYTES - LDSCTL_OFF) / 4; u += NWAVES * 64) ((LAS unsigned*)(lds + LDSCTL_OFF))[u] = 0u;
    __syncthreads();
    XcdBarrier bar; bar.bar = (unsigned*)(ws + WS_CTL + CTL_BAR); bar.x = 0; bar.st = nullptr;
    if (args.ph_hi - args.ph_lo > 1) bar = xcd_barrier_post((unsigned*)(ws + WS_CTL + CTL_BAR), (volatile LAS unsigned*)(lds + MISC_OFF) + 8);
    const int lo = args.ph_lo, hi = args.ph_hi;
#ifndef PHASES
#define PHASES 0xFF
#endif
#define IN(k) ((((PHASES) >> (k)) & 1) && lo <= (k) && (k) < hi)
#define SEAM(k) do { if (IN(k) && IN((k) + 1)) { xcd_barrier(bar); } } while (0)
    const bool dry = args.dry != 0;
    float* dmy_out = (float*)(ws + WS_DUMMY); float* dmy_rss = (float*)(ws + WS_DUMMY + 64 * MiB); f16_t* dmy_mix = (f16_t*)(ws + WS_DUMMY);
    const int gw = vcu * NWAVES + wave, NGW = G * NWAVES;

    if (IN(0)) {
        const int lane = tid & 63;
        constexpr int I_IN = (D / 8) * (INW / 256), I_OUT = (D / 8) * (D / 256), I_UP = (D / 8) * (2 * DFF / 256), I_DN = (DFF / 8) * (D / 256), I_PG = I_OUT, I_PP = (PLE / 8) * (D / 256);
        constexpr int NITEMS = I_IN + I_OUT + I_UP + I_DN + I_PG + I_PP;
        for (int it = gw; it < NITEMS; it += NGW) {
            int r = it; const float* W; f16_t* WT; const float* gain; int K_, N_, half;
            if (r < I_IN) { W = w_in; WT = Win_t; gain = norm_mix_g; K_ = D; N_ = INW; half = CONV_CH; }
            else if ((r -= I_IN) < I_OUT) { W = w_out; WT = Wout_t; gain = nullptr; K_ = D; N_ = D; half = 0; }
            else if ((r -= I_OUT) < I_UP) { W = w_ffn_up; WT = Wup_t; gain = norm_ffn_g; K_ = D; N_ = 2 * DFF; half = DFF; }
            else if ((r -= I_UP) < I_DN) { W = w_ffn_down; WT = Wdn_t; gain = nullptr; K_ = DFF; N_ = D; half = 0; }
            else if ((r -= I_DN) < I_PG) { W = w_ple_gate; WT = Wpg_t; gain = norm_ple_g; K_ = D; N_ = D; half = 0; }
            else { r -= I_PG; W = w_ple_proj; WT = Wpp_t; gain = nullptr; K_ = PLE; N_ = D; half = 0; }
            const int nkb = K_ / 8, nb = r / nkb, kb = r % nkb, k0 = 8 * kb, n = 256 * nb + 4 * lane;
            f32x4 v[8];
#pragma unroll
            for (int j = 0; j < 8; ++j) v[j] = *(const f32x4*)(W + (size_t)(k0 + j) * N_ + n);
            if (gain) {
#pragma unroll
                for (int j = 0; j < 8; ++j) v[j] = v[j] * gain[k0 + j];
            }
            const int drow = (half && n < 2 * half) ? glu_row(n, half) : n;
#pragma unroll
            for (int e = 0; e < 4; ++e) { u32x4 o; o.x = pkh(v[0][e], v[1][e]); o.y = pkh(v[2][e], v[3][e]); o.z = pkh(v[4][e], v[5][e]); o.w = pkh(v[6][e], v[7][e]);
                *(u32x4*)(WT + (size_t)(drow + e) * K_ + k0) = o; }
        }
        for (int i = vcu * 512 + tid; i < 32 * CONV_CH; i += G * 512) CW16[i] = (i < CONVK * CONV_CH) ? (f16_t)conv_w[i] : (f16_t)0.f;
        for (int m = 2 * gw; m < M; m += 2 * NGW) {
            const f32x4* xr = (const f32x4*)(x + (size_t)m * D) + lane;
            f32x4 v[2][4]; float s2[2] = {0.f, 0.f};
#pragma unroll
            for (int q = 0; q < 2; ++q)
#pragma unroll
                for (int j = 0; j < 4; ++j) v[q][j] = xr[q * (D / 4) + 64 * j];
#pragma unroll
            for (int q = 0; q < 2; ++q)
#pragma unroll
                for (int j = 0; j < 4; ++j) s2[q] += (v[q][j][0] * v[q][j][0] + v[q][j][1] * v[q][j][1]) + (v[q][j][2] * v[q][j][2] + v[q][j][3] * v[q][j][3]);
#pragma unroll
            for (int q = 0; q < 2; ++q) {
                const float rstd = 1.0f / sqrtf(wave_sum(s2[q]) * (1.0f / D) + EPS);
                u32x2* o8 = (u32x2*)(XN + (size_t)(m + q) * D) + lane;
#pragma unroll
                for (int j = 0; j < 4; ++j) { u32x2 w; w.x = pkh(v[q][j][0] * rstd, v[q][j][1] * rstd); w.y = pkh(v[q][j][2] * rstd, v[q][j][3] * rstd); o8[64 * j] = w; }
            }
        }
        { const size_t n8 = (size_t)M * PLE / 8, stride = (size_t)G * 512;
          for (size_t i = (size_t)(vcu * 512 + tid); i < n8; i += 4 * stride) {
            f32x4 a[4], b[4];
#pragma unroll
            for (int q = 0; q < 4; ++q) { const size_t ii = (i + q * stride < n8) ? i + q * stride : n8 - 1; a[q] = *((const f32x4*)p + 2 * ii); b[q] = *((const f32x4*)p + 2 * ii + 1); }
#pragma unroll
            for (int q = 0; q < 4; ++q) if (i + q * stride < n8) { u32x4 w; w.x = pkh(a[q][0], a[q][1]); w.y = pkh(a[q][2], a[q][3]); w.z = pkh(b[q][0], b[q][1]); w.w = pkh(b[q][2], b[q][3]);
                *((u32x4*)P16 + i + q * stride) = w; }
          } }
        for (int i = vcu * 512 + tid; i < M * 8; i += G * 512) {
            const int m = i >> 3, f = i & 7;
            const float invf = (f == 0) ? 1.0f : (f == 1) ? 0.1939227432012558f : (f == 2) ? 0.03760603070259094f : (f == 3) ? 0.007292664609849453f : (f == 4) ? 0.0014142135623842478f
                             : (f == 5) ? 0.00027424818836152554f : (f == 6) ? 5.318296098266728e-05f : 1.0313386155758053e-05f;
            const float ang = (float)positions[m] * invf;
            float sn, cs; sincos_d((double)ang, sn, cs);
            ropec[i] = cs; ropes[i] = sn;
        }
    }
    SEAM(0);

    if (IN(1)) {
        { pg8::Gemm g{XN, Win_t, M, INW, D}; pg8::StaticOrder S; S.init(M, INW, G, bx);
          pg8::EpiIn E{Ub, MIX, Kb, Vb, ropec, ropes, kms};
          pg8::gemm_phase<pg8::EpiIn, pg8::StaticOrder, true, true>(lds + RING_OFF, g, S, E); }
        { pg8::Gemm g{P16, Wpp_t, M, D, PLE};
          pg8::StaticOrder S; if (G == 256) S.init(M, D, 128, bx & 127); else S.init(M, D, G, bx);
          pg8::EpiF16 E{PP, D};
          if (G != 256 || bx >= 128) pg8::gemm_phase<pg8::EpiF16, pg8::StaticOrder, true, true>(lds + RING_OFF, g, S, E); }
    }
    SEAM(1);

    if (IN(2)) {
#ifndef PROBE_P2_PART
#define PROBE_P2_PART 0
#endif
#ifndef NO_ATTN
        if (!(dry && PROBE_P2_PART == 2)) {
        const int nattn = BATCH * NHEAD * 4;
        for (int v = vcu; v < nattn; v += G) {
            const int bh = v >> 2, s = v & 3;
            for (int i = 0; i < 2; ++i) {
                const int qb = i == 0 ? 7 - s : s;
                unsigned sel = 0xFFFFFFFFu;
                if (qb > 3) sel = attn_body::moba_select(bh / NHEAD, bh % NHEAD, qb, MIX + AW, kms);
                asm volatile("" : "+v"(sel) :: "memory"); __builtin_amdgcn_sched_barrier(0);
                attn_body::attn_unit<8>(bh / NHEAD, bh % NHEAD, qb, MIX + AW, Kb, Vb, (dry ? dmy_mix : MIX) + AW, sel, (char*)lds_raw);
            }
        }
        }
#endif
#ifndef NO_CONV
        if (!(dry && PROBE_P2_PART == 1))
        {
            LAS f16_t* ut = (LAS f16_t*)(lds + RING_OFF);
            LAS f16_t* wt = (LAS f16_t*)(lds + RING_OFF + 95 * 1024);
            __syncthreads();
            { u32x4 wv[4];
#pragma unroll
              for (int q = 0; q < 4; ++q) wv[q] = *((const u32x4*)CW16 + tid + 512 * q);
#pragma unroll
              for (int q = 0; q < 4; ++q) *((LAS u32x4*)wt + tid + 512 * q) = wv[q]; }
            ut[94 * CONV_CH + tid] = (f16_t)0.f;
            const int lane = tid & 63; const int c0 = lane * 8;
            for (int cu = vcu; cu < M / 64; cu += G) {
                const int t0 = cu * 64; const int tb = t0 & (SEQ - 1);
                __syncthreads();
                { u32x4 uv[12];
#pragma unroll
                  for (int q = 0; q < 12; ++q) { const int i = tid + 512 * q; const int rr = i >> 6, ch = i & 63;
                      const bool ok = i < 94 * 64 && tb - 30 + rr >= 0;
                      const u32x4 ld = *(const u32x4*)(Ub + (ok ? (size_t)(t0 - 30 + rr) * CONV_CH + ch * 8 : (size_t)0));
                      uv[q] = ok ? ld : (u32x4){0u, 0u, 0u, 0u}; }
#pragma unroll
                  for (int q = 0; q < 12; ++q) { const int i = tid + 512 * q; if (i < 94 * 64) *((LAS u32x4*)ut + i) = uv[q]; } }
                __syncthreads();
                float acc[8][8];
#pragma unroll
                for (int i = 0; i < 8; ++i)
#pragma unroll
                    for (int e = 0; e < 8; ++e) acc[i][e] = 0.f;
                const LAS f16_t* ub = ut + (wave * 8) * CONV_CH + c0;
                const LAS f16_t* wb = wt + c0;
                f16x8 win[15];
#pragma unroll
                for (int i = 0; i < 7; ++i) win[8 + i] = *(const LAS f16x8*)(ub + i * CONV_CH);
#pragma unroll 1
                for (int jj = 0; jj < 32; jj += 8) {
#pragma unroll
                    for (int i = 0; i < 7; ++i) win[i] = win[8 + i];
#pragma unroll
                    for (int i = 0; i < 8; ++i) win[7 + i] = *(const LAS f16x8*)(ub + (jj + 7 + i) * CONV_CH);
#pragma unroll
                    for (int dj = 0; dj < 8; ++dj) {
                        const f16x8 wj = *(const LAS f16x8*)(wb + (jj + dj) * CONV_CH);
#pragma unroll
                        for (int i = 0; i < 8; ++i)
#pragma unroll
                            for (int e = 0; e < 8; ++e) acc[i][e] += (float)wj[e] * (float)win[dj + i][e];
                    }
                }
                float gam[8], bet[8], cb[8];
#pragma unroll
                for (int e = 0; e < 8; ++e) { gam[e] = conv_ln_g[c0 + e]; bet[e] = conv_ln_b[c0 + e]; cb[e] = conv_b[c0 + e]; }
#pragma unroll
                for (int i = 0; i < 8; ++i) {
                    float s = 0.f;
#pragma unroll
                    for (int e = 0; e < 8; ++e) { acc[i][e] += cb[e]; s += acc[i][e]; }
                    const float mu = wave_sum(s) * (1.0f / CONV_CH);
                    float q = 0.f;
#pragma unroll
                    for (int e = 0; e < 8; ++e) { const float d = acc[i][e] - mu; q += d * d; }
                    const float rstd = 1.0f / sqrtf(wave_sum(q) * (1.0f / CONV_CH) + EPS);
                    float y[8];
#pragma unroll
                    for (int e = 0; e < 8; ++e) { const float z = (acc[i][e] - mu) * rstd * gam[e] + bet[e]; y[e] = z * sigmoidf_(z); }
                    u32x4 w; w.x = pkh(y[0], y[1]); w.y = pkh(y[2], y[3]); w.z = pkh(y[4], y[5]); w.w = pkh(y[6], y[7]);
                    *(u32x4*)(MIX + (size_t)(t0 + wave * 8 + i) * D + c0) = w;
                }
            }
            __syncthreads();
        }
#endif
    }
    SEAM(2);

    if (IN(3)) {
        pg8::Gemm g{MIX, Wout_t, M, D, D}; pg8::StaticOrder S; S.init(M, D, G, bx);
        pg8::EpiRes<false> E{x, XN, dry ? dmy_rss : rss1};
        pg8::gemm_phase<pg8::EpiRes<false>, pg8::StaticOrder, true, true>(lds + RING_OFF, g, S, E);
    }
    SEAM(3);

    if (IN(4)) {
        pg8::Gemm g{XN, Wup_t, M, 2 * DFF, D}; pg8::StaticOrder S; S.init(M, 2 * DFF, G, bx);
        pg8::EpiUp E{HID, rss1};
        pg8::gemm_phase<pg8::EpiUp, pg8::StaticOrder, true, true>(lds + RING_OFF, g, S, E);
    }
    SEAM(4);

    if (IN(5)) {
        pg8::Gemm g{HID, Wdn_t, M, D, DFF}; pg8::StaticOrder S; S.init(M, D, G, bx);
        pg8::EpiRes<true> E{XN, dry ? (f16_t*)dmy_out : XN, dry ? dmy_rss : rss2};
        pg8::gemm_phase<pg8::EpiRes<true>, pg8::StaticOrder, true, true>(lds + RING_OFF, g, S, E);
    }
    SEAM(5);

    if (IN(6)) {
        pg8::Gemm g{XN, Wpg_t, M, D, D}; pg8::StaticOrder S; S.init(M, D, G, bx);
        pg8::EpiGate E{XN, dry ? dmy_out : out, PP, rss2, dry ? dmy_rss : rss3};
        pg8::gemm_phase<pg8::EpiGate, pg8::StaticOrder, true, true>(lds + RING_OFF, g, S, E);
    }
    SEAM(6);

    if (IN(7)) {
        int t7_ = threadIdx.x; asm volatile("" : "+v"(t7_)); const int lane = t7_ & 63;
        f32x4 gv[4];
#pragma unroll
        for (int j = 0; j < 4; ++j) gv[j] = *((const f32x4*)final_norm_g + lane + 64 * j);
        for (int m = gw; m < M; m += NGW) {
            const float rs = 1.0f / sqrtf(rss3[m] * (1.0f / D) + EPS);
            const f32x4* xr = (const f32x4*)(out + (size_t)m * D) + lane; f32x4* yr = (f32x4*)((dry ? dmy_out : out) + (size_t)m * D) + lane;
#pragma unroll
            for (int j = 0; j < 4; ++j) { f32x4 v = xr[64 * j]; v = v * rs * gv[j]; yr[64 * j] = v; }
        }
    }
#undef IN
#undef SEAM
}

extern "C" void kernel_launch(void* const* d_in, const int* in_sizes, int n_in, void* d_out, int out_size, void* d_ws, size_t ws_size, hipStream_t stream) {
    static int grid = 0;
    if (grid == 0) {
        if (n_in != 17 || out_size != M * D || ws_size < WS_END + 65 * MiB) { fprintf(stderr, "kernel_launch: unexpected shapes (n_in %d, out %d, ws %zu)\n", n_in, out_size, ws_size); grid = -1; return; }
        int dev = 0, cus = 0, per_cu = 0;
        if (hipGetDevice(&dev) != hipSuccess || hipDeviceGetAttribute(&cus, hipDeviceAttributeMultiprocessorCount, dev) != hipSuccess) { grid = -1; return; }
        if (hipFuncSetAttribute((const void*)fwd_kernel, hipFuncAttributeMaxDynamicSharedMemorySize, LDS_BYTES) != hipSuccess) { fprintf(stderr, "kernel_launch: hipFuncSetAttribute failed\n"); grid = -1; return; }
        if (hipOccupancyMaxActiveBlocksPerMultiprocessor(&per_cu, (const void*)fwd_kernel, NWAVES * 64, LDS_BYTES) != hipSuccess || per_cu < 1) { fprintf(stderr, "kernel_launch: occupancy query says %d\n", per_cu); per_cu = 1; }
        (void)hipGetLastError();
        grid = cus;
    }
    if (grid < 0) return;
    (void)hipMemsetAsync((char*)d_ws + WS_CTL, 0, CTL_ZERO_BYTES, stream);
    Args a{};
    for (int i = 0; i < 17; ++i) a.in[i] = d_in[i];
    a.out = (float*)d_out; a.ws = (unsigned char*)d_ws;
#ifndef MK_ONE_LAUNCH
#ifndef PROBE_MASK
#define PROBE_MASK 0
#endif
#ifndef PROBE_REPS
#define PROBE_REPS 1
#endif
    for (int ph = 0; ph < 8; ++ph) {
        a.ph_lo = ph; a.ph_hi = ph + 1;
        if ((PROBE_MASK >> ph) & 1) for (int r = 0; r < PROBE_REPS; ++r) { a.dry = 1; hipLaunchKernelGGL(fwd_kernel, dim3(grid), dim3(NWAVES * 64), LDS_BYTES, stream, a); }
        a.dry = 0;
        hipLaunchKernelGGL(fwd_kernel, dim3(grid), dim3(NWAVES * 64), LDS_BYTES, stream, a);
    }
#else
    a.ph_lo = 0; a.ph_hi = 8;
    void* kargs[] = {&a};
    hipError_t e = hipLaunchCooperativeKernel((const void*)fwd_kernel, dim3(grid), dim3(NWAVES * 64), kargs, LDS_BYTES, stream);
    if (e != hipSuccess) fprintf(stderr, "cooperative launch failed: %s (grid %d)\n", hipGetErrorString(e), grid);
#endif
}
```
